# Optimizing an MI355X kernel written in HIP

```python
import math
import jax
import jax.numpy as jnp
from jax import lax
import numpy as np

D_MODEL = 1024
BATCH = 2
SEQ = 8192
DEPTH = 1

N_HEADS = 8
HEAD_DIM = 64
ATTN_WIDTH = N_HEADS * HEAD_DIM
MOBA_BLOCK = 256
MOBA_TOPK = 3
MOBA_Q_CHUNK = 64
POOL_WINDOWS = (2, 4, 8, 16)
POOL_GROUPS = len(POOL_WINDOWS)
POOL_WIDTH = D_MODEL // 2
POOL_GROUP_WIDTH = POOL_WIDTH // POOL_GROUPS
N_BRANCHES = 2
IN_WIDTH = 3 * ATTN_WIDTH + POOL_WIDTH + N_BRANCHES * D_MODEL
REL_BUCKETS = 32
REL_MAX_DIST = 128
N_EXPERT_GROUPS = 4
EXPERTS_PER_GROUP = 8
N_EXPERTS = N_EXPERT_GROUPS * EXPERTS_PER_GROUP
EXPERT_TOPK = 2
D_EXPERT = D_MODEL // 2
N_MOD = 6
EPS = 1e-6
NEG_INF = -1e30

kernel_name = "hybrid_moba_pool_hmoe_adaln_block"


def rms_norm(x, g):
    xf = x.astype(jnp.float32)
    xf = xf * lax.rsqrt(jnp.mean(xf * xf, axis=-1, keepdims=True) + EPS)
    return (xf * g.astype(jnp.float32)).astype(x.dtype)


def t5_bucket(rel):
    n = jnp.maximum(rel, 0)
    max_exact = REL_BUCKETS // 2
    nf = jnp.maximum(n, 1).astype(jnp.float32)
    large = max_exact + (jnp.log(nf / max_exact) / math.log(REL_MAX_DIST / max_exact)
                         * (REL_BUCKETS - max_exact)).astype(jnp.int32)
    large = jnp.minimum(large, REL_BUCKETS - 1)
    return jnp.where(n < max_exact, n, large)


def moba_attention(q, k, v, rel_bias):
    B, S, H, Dh = q.shape
    nb = -(-S // MOBA_BLOCK)
    pad = nb * MOBA_BLOCK - S
    topk = min(MOBA_TOPK, nb)
    scale = Dh ** -0.5
    qh = q.transpose(0, 2, 1, 3)
    kp = jnp.pad(k.transpose(0, 2, 1, 3), ((0, 0), (0, 0), (0, pad), (0, 0)))
    vp = jnp.pad(v.transpose(0, 2, 1, 3), ((0, 0), (0, 0), (0, pad), (0, 0)))
    kb = kp.reshape(B, H, nb, MOBA_BLOCK, Dh)
    vb = vp.reshape(B, H, nb, MOBA_BLOCK, Dh)
    k_mean = jnp.mean(kb.astype(jnp.float32), axis=3)
    bias_t = rel_bias.T
    b_idx = jnp.arange(B)[:, None, None, None]
    h_idx = jnp.arange(H)[None, :, None, None]
    h_idx5 = jnp.arange(H)[None, :, None, None, None]
    blk_offsets = jnp.arange(MOBA_BLOCK)

    def attend_chunk(ci):
        q0 = ci * MOBA_Q_CHUNK
        blk = q0 // MOBA_BLOCK
        qc = lax.dynamic_slice_in_dim(qh, q0, MOBA_Q_CHUNK, axis=2)
        qpos = q0 + jnp.arange(MOBA_Q_CHUNK)
        gate = jnp.einsum('bhqd,bhnd->bhqn', qc.astype(jnp.float32), k_mean)
        gate = jnp.where(jnp.arange(nb) < blk, gate, -jnp.inf)
        _, sel = lax.top_k(gate, topk)
        sel_valid = sel < blk
        ks = kb[b_idx, h_idx, sel]
        vs = vb[b_idx, h_idx, sel]
        s_sel = jnp.einsum('bhqd,bhqjkd->bhqjk', qc, ks).astype(jnp.float32) * scale
        kpos_sel = sel[..., None] * MOBA_BLOCK + blk_offsets
        bucket_sel = t5_bucket(qpos[None, None, :, None, None] - kpos_sel)
        s_sel = s_sel + bias_t[h_idx5, bucket_sel].astype(jnp.float32)
        s_sel = jnp.where(sel_valid[..., None], s_sel, NEG_INF)
        ko = lax.dynamic_index_in_dim(kb, blk, axis=2, keepdims=False)
        vo = lax.dynamic_index_in_dim(vb, blk, axis=2, keepdims=False)
        s_own = jnp.einsum('bhqd,bhkd->bhqk', qc, ko).astype(jnp.float32) * scale
        rel_own = qpos[:, None] - (blk * MOBA_BLOCK + blk_offsets)[None, :]
        s_own = s_own + bias_t[:, t5_bucket(rel_own)][None].astype(jnp.float32)
        s_own = jnp.where(rel_own >= 0, s_own, NEG_INF)
        logits = jnp.concatenate(
            [s_sel.reshape(B, H, MOBA_Q_CHUNK, topk * MOBA_BLOCK), s_own], axis=-1)
        p = jax.nn.softmax(logits, axis=-1).astype(v.dtype)
        p_sel = p[..., :topk * MOBA_BLOCK].reshape(B, H, MOBA_Q_CHUNK, topk, MOBA_BLOCK)
        p_own = p[..., topk * MOBA_BLOCK:]
        return (jnp.einsum('bhqjk,bhqjkd->bhqd', p_sel, vs)
                + jnp.einsum('bhqk,bhkd->bhqd', p_own, vo))

    out = lax.map(attend_chunk, jnp.arange(S // MOBA_Q_CHUNK))
    return out.transpose(1, 0, 3, 2, 4).reshape(B, S, H * Dh)


def pool_mixer(u, pool_w, pool_scale):
    B, S, P = u.shape
    uf = u.astype(jnp.float32)
    cs = jnp.pad(jnp.cumsum(uf, axis=1), ((0, 0), (1, 0), (0, 0)))
    t = jnp.arange(S)
    outs = []
    for g, w in enumerate(POOL_WINDOWS):
        lo_c, hi_c = g * POOL_GROUP_WIDTH, (g + 1) * POOL_GROUP_WIDTH
        csg = cs[..., lo_c:hi_c]
        lo = jnp.maximum(t + 1 - w, 0)
        cnt = (t + 1 - lo).astype(jnp.float32)
        mean = (csg[:, 1:] - csg[:, lo]) / cnt[None, :, None]
        d = (mean - uf[..., lo_c:hi_c]).astype(u.dtype)
        outs.append(jnp.einsum('bsc,cd->bsd', d, pool_w[g]))
    return jnp.concatenate(outs, axis=-1) * pool_scale


def hier_moe(h, w_rg, b_rg, w_re, b_re, w_g, w_u, w_d):
    B, S, D = h.shape
    N = B * S
    hf = h.reshape(N, D)
    z_group = (hf @ w_rg).astype(jnp.float32) + b_rg.astype(jnp.float32)
    p_group = jax.nn.softmax(z_group, axis=-1)
    pg_top, g_idx = lax.top_k(p_group, 1)
    z_exp = ((hf @ w_re).astype(jnp.float32) + b_re.astype(jnp.float32)).reshape(
        N, N_EXPERT_GROUPS, EXPERTS_PER_GROUP)
    z_in_group = z_exp[jnp.arange(N), g_idx[:, 0]]
    ze_top, e_idx = lax.top_k(z_in_group, EXPERT_TOPK)
    weights = pg_top * jax.nn.softmax(ze_top, axis=-1)
    expert_id = g_idx * EXPERTS_PER_GROUP + e_idx
    combine = jnp.einsum('nk,nke->ne', weights,
                         jax.nn.one_hot(expert_id, N_EXPERTS, dtype=jnp.float32)).astype(h.dtype)
    y = jnp.zeros_like(hf)
    for e in range(N_EXPERTS):
        act = jax.nn.silu(hf @ w_g[e]) * (hf @ w_u[e])
        y = y + combine[:, e:e + 1] * (act @ w_d[e])
    return y.reshape(B, S, D)


def setup_inputs(seed: int = 0) -> dict:
    key = jax.random.key(seed)
    ks = jax.random.split(key, 22)
    f32 = jnp.float32
    D = D_MODEL
    PGW = POOL_GROUP_WIDTH

    def nrm(k, shape, s):
        return jax.random.normal(k, shape, f32) * s

    return {
        "x": nrm(ks[0], (BATCH, SEQ, D), 1.0),
        "c": nrm(ks[1], (BATCH, D), 1.0),
        "w_ada": nrm(ks[2], (DEPTH, D, N_MOD * D), 0.5 * D ** -0.5),
        "b_ada": nrm(ks[3], (DEPTH, N_MOD * D), 0.02),
        "norm1_g": 1.0 + nrm(ks[4], (DEPTH, D), 0.05),
        "w_in": nrm(ks[5], (DEPTH, D, IN_WIDTH), D ** -0.5),
        "b_gate": nrm(ks[6], (DEPTH, N_BRANCHES * D), 0.02),
        "rel_bias": nrm(ks[7], (REL_BUCKETS, N_HEADS), 0.5),
        "pool_w": nrm(ks[8], (DEPTH, POOL_GROUPS, PGW, PGW), PGW ** -0.5),
        "pool_scale": 1.0 + nrm(ks[9], (DEPTH, POOL_WIDTH), 0.1),
        "w_branch_attn": nrm(ks[10], (DEPTH, ATTN_WIDTH, D), ATTN_WIDTH ** -0.5),
        "w_branch_pool": nrm(ks[11], (DEPTH, POOL_WIDTH, D), POOL_WIDTH ** -0.5),
        "w_out": nrm(ks[12], (DEPTH, D, D), D ** -0.5),
        "norm2_g": 1.0 + nrm(ks[13], (DEPTH, D), 0.05),
        "w_router_group": nrm(ks[14], (DEPTH, D, N_EXPERT_GROUPS), D ** -0.5),
        "b_router_group": nrm(ks[15], (DEPTH, N_EXPERT_GROUPS), 0.01),
        "w_router_expert": nrm(ks[16], (DEPTH, D, N_EXPERTS), D ** -0.5),
        "b_router_expert": nrm(ks[17], (DEPTH, N_EXPERTS), 0.01),
        "w_expert_gate": nrm(ks[18], (DEPTH, N_EXPERTS, D, D_EXPERT), D ** -0.5),
        "w_expert_up": nrm(ks[19], (DEPTH, N_EXPERTS, D, D_EXPERT), D ** -0.5),
        "w_expert_down": nrm(ks[20], (DEPTH, N_EXPERTS, D_EXPERT, D), D_EXPERT ** -0.5),
        "norm_f_g": 1.0 + nrm(ks[21], (D,), 0.05),
    }


def reference(x, c, w_ada, b_ada, norm1_g, w_in, b_gate, rel_bias, pool_w, pool_scale,
              w_branch_attn, w_branch_pool, w_out, norm2_g, w_router_group, b_router_group,
              w_router_expert, b_router_expert, w_expert_gate, w_expert_up, w_expert_down,
              norm_f_g):
    B, S, D = x.shape
    c_act = jax.nn.silu(c)
    split_pts = [ATTN_WIDTH, 2 * ATTN_WIDTH, 3 * ATTN_WIDTH, 3 * ATTN_WIDTH + POOL_WIDTH]
    for l in range(DEPTH):
        mod = (c_act @ w_ada[l] + b_ada[l])[:, None, :]
        shift1, scale1, gate1, shift2, scale2, gate2 = jnp.split(mod, N_MOD, axis=-1)
        h = rms_norm(x, norm1_g[l]) * (1 + scale1) + shift1
        proj = h @ w_in[l]
        q, k, v, u, z_gate = jnp.split(proj, split_pts, axis=-1)
        q = q.reshape(B, S, N_HEADS, HEAD_DIM)
        k = k.reshape(B, S, N_HEADS, HEAD_DIM)
        v = v.reshape(B, S, N_HEADS, HEAD_DIM)
        y_attn = moba_attention(q, k, v, rel_bias) @ w_branch_attn[l]
        y_pool = pool_mixer(u, pool_w[l], pool_scale[l]) @ w_branch_pool[l]
        g_attn, g_pool = jnp.split(jax.nn.sigmoid(z_gate + b_gate[l]), N_BRANCHES, axis=-1)
        mixed = (g_attn * y_attn + g_pool * y_pool) @ w_out[l]
        x = x + gate1 * mixed
        h2 = rms_norm(x, norm2_g[l]) * (1 + scale2) + shift2
        y_moe = hier_moe(h2, w_router_group[l], b_router_group[l], w_router_expert[l],
                         b_router_expert[l], w_expert_gate[l], w_expert_up[l], w_expert_down[l])
        x = x + gate2 * y_moe
    return rms_norm(x, norm_f_g)
```

```cpp
#include <hip/hip_runtime.h>
#include <cstdio>
#include <cstdint>

constexpr int BATCH = 2, SEQ = 8192, D = 1024, NTOK = BATCH * SEQ;
constexpr int NH = 8, HD = 64, AW = 512, MBLK = 256, NBLK = SEQ / MBLK;
constexpr int PW = 512, PGW = 128;
constexpr int INW = 4096;
constexpr int NE = 32, DE = 512;
constexpr int NMOD = 6;
constexpr int MAXTILES = 160;
constexpr float EPS = 1e-6f;
constexpr float NEG_INF = -1e30f;

namespace pg8 {
#define PG8_LAS __attribute__((address_space(3)))
typedef unsigned short bf16_t;
typedef short bf16x8 __attribute__((ext_vector_type(8)));
typedef float f32x4 __attribute__((ext_vector_type(4)));
typedef unsigned u32x4 __attribute__((ext_vector_type(4)));
typedef unsigned u32x2 __attribute__((ext_vector_type(2)));
constexpr int BM = 256, BK = 64, HALF = 128, HTB = HALF * BK * 2  , STAGE_BYTES = 8 * HTB, NXCD = 8, WGM = 8;

__host__ __device__ __forceinline__ int lds_byte(int r, int c) { const int st = (r >> 4) * 2 + (c >> 5), rr = r & 15, cc = c & 31, ob = rr * 64 + cc * 2; return st * 1024 + (ob ^ (((ob >> 9) & 1) << 5)); }
__host__ __device__ __forceinline__ void stage_rc(int b, int& R, int& C) { const int st = b / 1024, sb = b % 1024, swz = sb ^ (((sb >> 9) & 1) << 5); R = (st >> 1) * 16 + swz / 64; C = (st & 1) * 32 + (swz % 64) / 2; }
__host__ __device__ __forceinline__ int perm32(int rho) { const int n = rho >> 4, i = rho & 15; return 8 * (i >> 2) + 4 * n + (i & 3); }

struct Unit { int pm, pn, e; };
struct Gemm { const bf16_t* A; const bf16_t* Bt; int M, N, K; size_t estride; };

struct StaticOrder {
    int nM, nN, nwg, G, c;
    __host__ __device__ void init(int M, int N, int G_, int c_) { nM = M / BM; nN = N / BM; nwg = nM * nN; G = G_; c = c_; }
    __host__ __device__ bool next(int i, Unit& u) const {
        const long L = (long)i * G + c; if (L >= nwg) return false;
        int wgid = (int)L; { const int q = nwg / NXCD, r = nwg % NXCD, xcd = wgid % NXCD, off = wgid / NXCD; wgid = (xcd < r ? xcd * (q + 1) : r * (q + 1) + (xcd - r) * q) + off; }
        const int nig = WGM * nN, gid = wgid / nig, fm = gid * WGM, gsz = (nM - fm) < WGM ? (nM - fm) : WGM;
        u.pm = fm + ((wgid % nig) % gsz); u.pn = (wgid % nig) / gsz; u.e = 0; return true;
    }
    __device__ __forceinline__ void a_ready(const Unit&) const {}
    __device__ __forceinline__ void done(const Unit&) const {}
};
struct GroupedOrder {
    StaticOrder so; const PG8_LAS int* tile_e;
    __device__ __forceinline__ bool next(int i, Unit& u) const {
        if (!so.next(i, u)) return false;
        u.e = __builtin_amdgcn_readfirstlane(tile_e[u.pm]); return true;
    }
    __device__ __forceinline__ void a_ready(const Unit&) const {}
    __device__ __forceinline__ void done(const Unit&) const {}
};

__device__ __forceinline__ unsigned cvt_pk_bf16(float lo, float hi) { unsigned r; asm volatile("v_cvt_pk_bf16_f32 %0, %1, %2" : "=v"(r) : "v"(lo), "v"(hi)); return r; }
__device__ __forceinline__ float bf_lo(unsigned u) { return __uint_as_float(u << 16); }
__device__ __forceinline__ float bf_hi(unsigned u) { return __uint_as_float(u & 0xffff0000u); }
__device__ __forceinline__ float sigm(float x) { return 1.0f / (1.0f + __expf(-x)); }
__device__ __forceinline__ u32x4 pack8(const f32x4 v0, const f32x4 v1) { u32x4 w; w.x = cvt_pk_bf16(v0[0], v0[1]); w.y = cvt_pk_bf16(v0[2], v0[3]); w.z = cvt_pk_bf16(v1[0], v1[1]); w.w = cvt_pk_bf16(v1[2], v1[3]); return w; }

struct EpiProj {
    static constexpr bool PERM = true, AFTER_DRAIN = false;
    bf16_t* O; const float* bgate;
    __device__ __forceinline__ void operator()(const f32x4 (&acc)[2][2][4][2], const Unit& u, int wr, int wc, int fr, int fq) const {
        const int t = u.pn >> 1, colt = (u.pn & 1) * 256; const bool gate = t >= 4;
        bf16_t* base = O + (size_t)t * ((size_t)NTOK * 512);
        const int row0 = u.pm * BM + wr * 64 + fr, col0 = colt + wc * 32 + 8 * fq, bcol0 = u.pn * BM - 2048 + wc * 32 + 8 * fq;
        f32x4 bv[2][2];
#pragma unroll
        for (int bj = 0; bj < 2; ++bj)
#pragma unroll
            for (int n = 0; n < 2; ++n) bv[bj][n] = gate ? *(const f32x4*)(bgate + bcol0 + bj * HALF + 4 * n) : (f32x4){0.f, 0.f, 0.f, 0.f};
#pragma unroll
        for (int ai = 0; ai < 2; ++ai)
#pragma unroll
            for (int m = 0; m < 4; ++m) { bf16_t* rowp = base + (size_t)(row0 + ai * HALF + m * 16) * 512 + col0;
#pragma unroll
                for (int bj = 0; bj < 2; ++bj) { f32x4 v0 = acc[ai][bj][m][0] + bv[bj][0], v1 = acc[ai][bj][m][1] + bv[bj][1];
                    if (gate) {
#pragma unroll
                        for (int j = 0; j < 4; ++j) { v0[j] = sigm(v0[j]); v1[j] = sigm(v1[j]); } }
                    *(u32x4*)(rowp + bj * HALF) = pack8(v0, v1); } }
    }
};
template <bool SECOND> struct EpiGate {
    static constexpr bool PERM = true, AFTER_DRAIN = false;
    const bf16_t* G; bf16_t* T;
    __device__ __forceinline__ void operator()(const f32x4 (&acc)[2][2][4][2], const Unit& u, int wr, int wc, int fr, int fq) const {
        const bf16_t* gbase = G + (size_t)(u.pn >> 1) * ((size_t)NTOK * 512);
        const int row0 = u.pm * BM + wr * 64 + fr, gcol0 = (u.pn & 1) * 256 + wc * 32 + 8 * fq, col0 = u.pn * BM + wc * 32 + 8 * fq;
#pragma unroll
        for (int ai = 0; ai < 2; ++ai)
#pragma unroll
            for (int m = 0; m < 4; ++m) { const int r = row0 + ai * HALF + m * 16;
#pragma unroll
                for (int bj = 0; bj < 2; ++bj) {
                    const u32x4 gv = *(const u32x4*)(gbase + (size_t)r * 512 + gcol0 + bj * HALF);
                    bf16_t* tp = T + (size_t)r * 1024 + col0 + bj * HALF;
                    f32x4 v0 = acc[ai][bj][m][0] * (f32x4){bf_lo(gv.x), bf_hi(gv.x), bf_lo(gv.y), bf_hi(gv.y)};
                    f32x4 v1 = acc[ai][bj][m][1] * (f32x4){bf_lo(gv.z), bf_hi(gv.z), bf_lo(gv.w), bf_hi(gv.w)};
                    if (SECOND) { const u32x4 tv = *(const u32x4*)tp;
                        v0 += (f32x4){bf_lo(tv.x), bf_hi(tv.x), bf_lo(tv.y), bf_hi(tv.y)}; v1 += (f32x4){bf_lo(tv.z), bf_hi(tv.z), bf_lo(tv.w), bf_hi(tv.w)}; }
                    *(u32x4*)tp = pack8(v0, v1); } }
    }
};
struct EpiRes {
    static constexpr bool PERM = false, AFTER_DRAIN = false;
    const float* x; float* out; const float* mod;
    __device__ __forceinline__ void operator()(const f32x4 (&acc)[2][2][4][2], const Unit& u, int wr, int wc, int fr, int fq) const {
        const int b = (u.pm * BM) / SEQ; const float* gp = mod + b * (NMOD * D) + 2 * D;
        const int row0 = u.pm * BM + wr * 64 + fr, col0 = u.pn * BM + wc * 32 + 4 * fq;
        f32x4 gv[2][2];
#pragma unroll
        for (int bj = 0; bj < 2; ++bj)
#pragma unroll
            for (int n = 0; n < 2; ++n) gv[bj][n] = *(const f32x4*)(gp + col0 + bj * HALF + n * 16);
#pragma unroll
        for (int ai = 0; ai < 2; ++ai)
#pragma unroll
            for (int m = 0; m < 4; ++m) { const size_t off = (size_t)(row0 + ai * HALF + m * 16) * D + col0;
#pragma unroll
                for (int bj = 0; bj < 2; ++bj)
#pragma unroll
                    for (int n = 0; n < 2; ++n) { const f32x4 xs = *(const f32x4*)(x + off + bj * HALF + n * 16); *(f32x4*)(out + off + bj * HALF + n * 16) = xs + gv[bj][n] * acc[ai][bj][m][n]; } }
    }
};
struct EpiSwiglu {
    static constexpr bool PERM = false, AFTER_DRAIN = false;
    bf16_t* act;
    __device__ __forceinline__ void operator()(const f32x4 (&acc)[2][2][4][2], const Unit& u, int wr, int wc, int fr, int fq) const {
        const int row0 = u.pm * BM + wr * 64 + fr, col0 = u.pn * 128 + wc * 16 + 4 * fq;
#pragma unroll
        for (int ai = 0; ai < 2; ++ai)
#pragma unroll
            for (int m = 0; m < 4; ++m) { bf16_t* rowp = act + (size_t)(row0 + ai * HALF + m * 16) * DE + col0;
#pragma unroll
                for (int bj = 0; bj < 2; ++bj) { const f32x4 g = acc[ai][bj][m][0], up = acc[ai][bj][m][1]; f32x4 a;
#pragma unroll
                    for (int j = 0; j < 4; ++j) a[j] = g[j] * sigm(g[j]) * up[j];
                    u32x2 w; w.x = cvt_pk_bf16(a[0], a[1]); w.y = cvt_pk_bf16(a[2], a[3]);
                    *(u32x2*)(rowp + bj * 64) = w; } }
    }
};
struct EpiY {
    static constexpr bool PERM = true, AFTER_DRAIN = false;
    bf16_t* Y;
    __device__ __forceinline__ void operator()(const f32x4 (&acc)[2][2][4][2], const Unit& u, int wr, int wc, int fr, int fq) const {
        const int row0 = u.pm * BM + wr * 64 + fr, col0 = u.pn * BM + wc * 32 + 8 * fq;
#pragma unroll
        for (int ai = 0; ai < 2; ++ai)
#pragma unroll
            for (int m = 0; m < 4; ++m) { bf16_t* rowp = Y + (size_t)(row0 + ai * HALF + m * 16) * D + col0;
#pragma unroll
                for (int bj = 0; bj < 2; ++bj) *(u32x4*)(rowp + bj * HALF) = pack8(acc[ai][bj][m][0], acc[ai][bj][m][1]); }
    }
};

template <class Epi, class Sched, bool ALIGN_EPI = false, bool SP2 = false>
__device__ __forceinline__ void gemm_phase(PG8_LAS unsigned char* lds, const Gemm g, const Sched& S, const Epi& E) {
    const int tid = threadIdx.x, wid = __builtin_amdgcn_readfirstlane(tid >> 6), lane = tid & 63, wr = wid >> 2, wc = wid & 3, fr = lane & 15, fq = lane >> 4;
    const int K = g.K, nt = K / BK;
    unsigned voffA[2], voffB[2];
#pragma unroll
    for (int i = 0; i < 2; ++i) { int R, C; stage_rc(tid * 16 + i * 8192, R, C); const int Rb = Epi::PERM ? ((R & ~31) + perm32(R & 31)) : R;
        voffA[i] = (unsigned)(R * K + C) * 2u; voffB[i] = (unsigned)(Rb * K + C) * 2u; }
    const size_t kstep = (size_t)(BK * 2);
    const size_t hstep = (size_t)HALF * K * 2;
    const size_t tstep = 2 * hstep;
    const unsigned ldsw = (unsigned)wid * 1024u;
    const int aoff = lds_byte(wr * 64 + fr, fq * 8), boff = lds_byte(wc * 32 + fr, fq * 8);
#define PG8_SA(b, h) (((b) * 2 + (h)) * HTB)
#define PG8_SB(b, h) ((4 + (b) * 2 + (h)) * HTB)
#define PG8_STAGE(bufoff, gbase, voff) do { _Pragma("unroll") for (int _i = 0; _i < 2; ++_i) \
        __builtin_amdgcn_global_load_lds((const unsigned*)((const char*)(gbase) + (voff)[_i]), (PG8_LAS unsigned*)(lds + (bufoff) + ldsw + _i * 8192), 16, 0, 0); } while (0)
#define PG8_LDA(dst, b, h) do { _Pragma("unroll") for (int m = 0; m < 4; ++m) _Pragma("unroll") for (int k = 0; k < 2; ++k) dst[m][k] = *(const PG8_LAS bf16x8*)(lds + PG8_SA(b, h) + aoff + m * 2048 + k * 1024); } while (0)
#define PG8_LDB(dst, b, h) do { _Pragma("unroll") for (int n = 0; n < 2; ++n) _Pragma("unroll") for (int k = 0; k < 2; ++k) dst[n][k] = *(const PG8_LAS bf16x8*)(lds + PG8_SB(b, h) + boff + n * 2048 + k * 1024); } while (0)
#define PG8_MMA(ai, bj, At, Bt) do { __builtin_amdgcn_s_setprio(1); _Pragma("unroll") for (int m = 0; m < 4; ++m) _Pragma("unroll") for (int n = 0; n < 2; ++n) _Pragma("unroll") for (int k = 0; k < 2; ++k) \
        acc[ai][bj][m][n] = __builtin_amdgcn_mfma_f32_16x16x32_bf16(Bt[n][k], At[m][k], acc[ai][bj][m][n], 0, 0, 0); __builtin_amdgcn_s_setprio(0); } while (0)
#define PG8_WAIT_V(n) asm volatile("s_waitcnt vmcnt(" #n ")" ::: "memory")
#define PG8_WAIT_L(n) asm volatile("s_waitcnt lgkmcnt(" #n ")" ::: "memory")
#define PG8_BAR __builtin_amdgcn_s_barrier()
#define PG8_SCHED __builtin_amdgcn_sched_barrier(0)
    Unit cur, nxt; int ui = 0;
    if (!S.next(0, cur)) return;
    f32x4 acc[2][2][4][2];
#pragma unroll
    for (int a = 0; a < 2; ++a)
#pragma unroll
        for (int b = 0; b < 2; ++b)
#pragma unroll
            for (int m = 0; m < 4; ++m)
#pragma unroll
                for (int n = 0; n < 2; ++n) acc[a][b][m][n] = (f32x4){0.f, 0.f, 0.f, 0.f};
    bf16x8 At[4][2], B0[2][2], B1[2][2];
    const char* cA = (const char*)g.A + (size_t)cur.pm * tstep; const char* cB = (const char*)g.Bt + (size_t)cur.e * g.estride + (size_t)cur.pn * tstep;
    S.a_ready(cur);
    if constexpr (SP2) {
        PG8_STAGE(PG8_SB(0, 0), cB, voffB); PG8_STAGE(PG8_SB(0, 1), cB + hstep, voffB); PG8_STAGE(PG8_SA(0, 0), cA, voffA); PG8_STAGE(PG8_SA(0, 1), cA + hstep, voffA);
        if (wr == 1) PG8_BAR;
        PG8_WAIT_V(2); PG8_BAR;
        PG8_STAGE(PG8_SB(1, 0), cB + kstep, voffB); PG8_STAGE(PG8_SA(1, 0), cA + kstep, voffA); PG8_STAGE(PG8_SB(1, 1), cB + hstep + kstep, voffB);
        PG8_WAIT_V(6); PG8_BAR;
    } else {
        PG8_STAGE(PG8_SB(0, 0), cB, voffB); PG8_STAGE(PG8_SA(0, 0), cA, voffA); PG8_STAGE(PG8_SB(0, 1), cB + hstep, voffB); PG8_STAGE(PG8_SA(0, 1), cA + hstep, voffA);
        if (wr == 1) PG8_BAR;
        PG8_WAIT_V(4); PG8_BAR;
        PG8_STAGE(PG8_SB(1, 0), cB + kstep, voffB); PG8_STAGE(PG8_SA(1, 0), cA + kstep, voffA); PG8_STAGE(PG8_SB(1, 1), cB + hstep + kstep, voffB);
        PG8_WAIT_V(6); PG8_BAR;
    }
    for (;;) {
        const bool has_next = S.next(ui + 1, nxt);
        const char* nA = has_next ? (const char*)g.A + (size_t)nxt.pm * tstep : cA; const char* nB = has_next ? (const char*)g.Bt + (size_t)nxt.e * g.estride + (size_t)nxt.pn * tstep : cB;
        for (int t = 0; t < nt; t += 2) {
            const bool last = (t == nt - 2);
            const char* a1 = cA + (size_t)(t + 1) * kstep;
            const char* a2 = last ? nA : cA + (size_t)(t + 2) * kstep; const char* b2 = last ? nB : cB + (size_t)(t + 2) * kstep;
            const char* a3 = a2 + kstep; const char* b3 = b2 + kstep;
            if (last && has_next) S.a_ready(nxt);
            if constexpr (SP2) {
            PG8_LDB(B0, 0, 0); PG8_LDB(B1, 0, 1); PG8_SCHED; PG8_LDA(At, 0, 0); PG8_STAGE(PG8_SA(1, 1), a1 + hstep, voffA);
            PG8_WAIT_V(8); PG8_WAIT_L(0); PG8_BAR; PG8_MMA(0, 0, At, B0); PG8_MMA(0, 1, At, B1); PG8_BAR; PG8_SCHED;
            PG8_LDA(At, 0, 1); PG8_STAGE(PG8_SB(0, 0), b2, voffB); PG8_STAGE(PG8_SB(0, 1), b2 + hstep, voffB); PG8_STAGE(PG8_SA(0, 0), a2, voffA);
            PG8_WAIT_V(8); PG8_WAIT_L(0); PG8_BAR; PG8_MMA(1, 0, At, B0); PG8_MMA(1, 1, At, B1); PG8_BAR; PG8_SCHED;
            PG8_LDB(B0, 1, 0); PG8_LDB(B1, 1, 1); PG8_SCHED; PG8_LDA(At, 1, 0); PG8_STAGE(PG8_SA(0, 1), a2 + hstep, voffA);
            PG8_WAIT_V(8); PG8_WAIT_L(0); PG8_BAR; PG8_MMA(0, 0, At, B0); PG8_MMA(0, 1, At, B1); PG8_BAR; PG8_SCHED;
            PG8_LDA(At, 1, 1); PG8_STAGE(PG8_SB(1, 0), b3, voffB); PG8_STAGE(PG8_SB(1, 1), b3 + hstep, voffB); PG8_STAGE(PG8_SA(1, 0), a3, voffA);
            PG8_WAIT_V(8); PG8_WAIT_L(0); PG8_BAR; PG8_MMA(1, 0, At, B0); PG8_MMA(1, 1, At, B1); PG8_BAR; PG8_SCHED;
            } else {
            PG8_LDB(B0, 0, 0); PG8_SCHED; PG8_LDA(At, 0, 0); PG8_STAGE(PG8_SA(1, 1), a1 + hstep, voffA);
            PG8_WAIT_L(8); PG8_BAR; PG8_WAIT_L(0); PG8_MMA(0, 0, At, B0); PG8_BAR; PG8_SCHED;
            PG8_LDB(B1, 0, 1); PG8_STAGE(PG8_SB(0, 0), b2, voffB);
            PG8_BAR; PG8_WAIT_L(0); PG8_MMA(0, 1, At, B1); PG8_BAR;
            PG8_LDA(At, 0, 1); PG8_STAGE(PG8_SA(0, 0), a2, voffA);
            PG8_BAR; PG8_WAIT_L(0); PG8_MMA(1, 0, At, B0); PG8_BAR; PG8_SCHED;
            PG8_STAGE(PG8_SB(0, 1), b2 + hstep, voffB);
            PG8_WAIT_V(6); PG8_BAR; PG8_MMA(1, 1, At, B1); PG8_BAR;
            PG8_LDB(B0, 1, 0); PG8_SCHED; PG8_LDA(At, 1, 0); PG8_STAGE(PG8_SA(0, 1), a2 + hstep, voffA);
            PG8_WAIT_L(8); PG8_BAR; PG8_WAIT_L(0); PG8_MMA(0, 0, At, B0); PG8_BAR; PG8_SCHED;
            PG8_LDB(B1, 1, 1); PG8_STAGE(PG8_SB(1, 0), b3, voffB);
            PG8_BAR; PG8_WAIT_L(0); PG8_MMA(0, 1, At, B1); PG8_BAR;
            PG8_LDA(At, 1, 1); PG8_STAGE(PG8_SA(1, 0), a3, voffA);
            PG8_BAR; PG8_WAIT_L(0); PG8_MMA(1, 0, At, B0); PG8_BAR; PG8_SCHED;
            PG8_STAGE(PG8_SB(1, 1), b3 + hstep, voffB);
            PG8_WAIT_V(6); PG8_BAR; PG8_MMA(1, 1, At, B1); PG8_BAR;
            }
        }
        if constexpr (ALIGN_EPI) { if (wr == 0) PG8_BAR; }
        if constexpr (!Epi::AFTER_DRAIN) { E(acc, cur, wr, wc, fr, fq); S.done(cur); }
        if (!has_next) break;
#pragma unroll
        for (int a = 0; a < 2; ++a)
#pragma unroll
            for (int b = 0; b < 2; ++b)
#pragma unroll
                for (int m = 0; m < 4; ++m)
#pragma unroll
                    for (int n = 0; n < 2; ++n) acc[a][b][m][n] = (f32x4){0.f, 0.f, 0.f, 0.f};
        cur = nxt; cA = nA; cB = nB; ++ui;
        if constexpr (ALIGN_EPI) { if (wr == 1) PG8_BAR; }
    }
    PG8_WAIT_V(0);
    if constexpr (!ALIGN_EPI) { if (wr == 0) PG8_BAR; }
    PG8_BAR;
    if constexpr (Epi::AFTER_DRAIN) { E.fused(acc, cur, wr, wc, fr, fq, lds, wid, lane); S.done(cur); }
#undef PG8_SA
#undef PG8_SB
#undef PG8_STAGE
#undef PG8_LDA
#undef PG8_LDB
#undef PG8_MMA
#undef PG8_WAIT_V
#undef PG8_WAIT_L
#undef PG8_BAR
#undef PG8_SCHED
}
}

constexpr int NWAVES = 8;
#ifndef MK_N_LAUNCHES
#define MK_N_LAUNCHES 1
#endif
constexpr int PER_PHASE = 12;
constexpr int N_LAUNCHES = MK_N_LAUNCHES;

constexpr size_t MiB = 1u << 20;
constexpr size_t WS_CTL = 0, CTL_ZERO_BYTES = 1 * MiB;
constexpr size_t WS_MOD = 1 * MiB;
constexpr size_t WS_KMEAN = 1 * MiB + 65536;
constexpr size_t WS_ROUTE = 2 * MiB;
constexpr size_t WS_LIST = 3 * MiB;
constexpr size_t WS_WIN = 5 * MiB, WS_WBA = 13 * MiB, WS_WBP = 14 * MiB, WS_WOUT = 15 * MiB, WS_WGU = 18 * MiB, WS_WD = 82 * MiB;
constexpr size_t WS_H = 114 * MiB;
constexpr size_t WS_AO = WS_H, WS_PO = WS_H + 16 * MiB;
constexpr size_t WS_PROJ = 146 * MiB;
constexpr size_t WS_T = 146 * MiB;
constexpr size_t WS_XG = 146 * MiB;
constexpr size_t WS_ACT = 226 * MiB;
constexpr size_t WS_Y = 146 * MiB;
constexpr size_t WS_END = 274 * MiB;
constexpr int CW_TMO = 0, CW_CODE = 1, CW_BAR = 4096, CW_ECNT = 16384;

constexpr int RING_OFF = 0, RING_BYTES = 131072;
constexpr int LDSCTL_OFF = RING_BYTES, MISC_OFF = LDSCTL_OFF + 320;
constexpr int TAB_OFF = LDSCTL_OFF + 512;
constexpr int BTAB_OFF = TAB_OFF, TOFF_OFF = TAB_OFF + 4096, ECNT_OFF = TOFF_OFF + 160, TILEE_OFF = ECNT_OFF + 128;
constexpr int LDS_BYTES = 147456;
static_assert(TILEE_OFF + 4 * MAXTILES <= LDS_BYTES, "LDS map");

#define GAS __attribute__((address_space(1)))
#define LAS __attribute__((address_space(3)))
typedef unsigned short bf16;
typedef unsigned v4u __attribute__((ext_vector_type(4)));
typedef unsigned v2u __attribute__((ext_vector_type(2)));
typedef float f32x4 __attribute__((ext_vector_type(4)));
typedef GAS unsigned gu32;
#define RLX_AGENT __ATOMIC_RELAXED, __HIP_MEMORY_SCOPE_AGENT
#define LDS_WAIT() asm volatile("s_waitcnt lgkmcnt(0)" ::: "memory")
#define VM_WAIT() asm volatile("s_waitcnt vmcnt(0)" ::: "memory")
__device__ __forceinline__ unsigned f2bf(float f) { unsigned u = __builtin_bit_cast(unsigned, f); return (u + 0x7fffu + ((u >> 16) & 1u)) >> 16; }
__device__ __forceinline__ unsigned pk2(float lo, float hi) { return f2bf(lo) | (f2bf(hi) << 16); }
__device__ __forceinline__ float bf2f(bf16 v) { return __uint_as_float(((unsigned)v) << 16); }

#define XB_TMO      128
#define XB_XCNT(j)  (256  + 64 * (j))
#define XB_XSUB(j)  (1280 + 64 * (j))
#define XB_XGEN(j)  (2304 + 64 * (j))
#define XB_TOP      3328
#define XB_TOPGEN   3392
#define XCD_BAR_WORDS 3456
#define XB_SPIN_CAP (1u << 18)
__device__ __forceinline__ unsigned xb_ld(unsigned* p)              { return __hip_atomic_load(p, __ATOMIC_RELAXED, __HIP_MEMORY_SCOPE_AGENT); }
__device__ __forceinline__ unsigned xb_add(unsigned* p, unsigned v) { return __hip_atomic_fetch_add(p, v, __ATOMIC_RELAXED, __HIP_MEMORY_SCOPE_AGENT); }
__device__ __forceinline__ unsigned xb_xcc_id() { return (unsigned)__builtin_amdgcn_s_getreg((3 << 11) | 20) & 0xFu; }
#define XB_SPIN(cond, bar) do { unsigned _sp = 0; while (cond) { __builtin_amdgcn_s_sleep(1); \
    if ((++_sp & 255u) == 0u) { if (xb_ld(&(bar)[XB_TMO])) break; if (_sp > XB_SPIN_CAP) { atomicAdd(&(bar)[XB_TMO], 1u); break; } } } } while (0)

struct XcdBarrier {
    unsigned* bar; unsigned x;
    volatile LAS unsigned* st;
};

__device__ __forceinline__ XcdBarrier xcd_barrier_post(unsigned* bar, volatile LAS unsigned* st) {
    XcdBarrier b; b.bar = bar; b.x = xb_xcc_id(); b.st = st;
    if (threadIdx.x == 0) (void)xb_add(&bar[XB_XCNT(b.x)], 1u);
    return b;
}
__device__ __forceinline__ void xcd_barrier_complete(unsigned* bar, unsigned x, unsigned& nloc, unsigned& nx) {
    const unsigned G = gridDim.x * gridDim.y * gridDim.z;
    unsigned sum, cnt, mine, sp = 0u;
    for (;;) {
        sum = 0u; cnt = 0u; mine = 0u;
#pragma unroll
        for (unsigned j = 0; j < 16; ++j) { const unsigned c = xb_ld(&bar[XB_XCNT(j)]); sum += c; cnt += (c > 0u) ? 1u : 0u; mine = (j == x) ? c : mine; }
        if (sum == G) break;
        __builtin_amdgcn_s_sleep(1);
        if ((++sp & 255u) == 0u) { if (xb_ld(&bar[XB_TMO])) break; if (sp > XB_SPIN_CAP) { atomicAdd(&bar[XB_TMO], 1u); break; } }
    }
    nloc = mine > 0u ? mine : 1u; nx = cnt > 0u ? cnt : 1u;
}

__device__ __forceinline__ void xcd_barrier(const XcdBarrier& b) {
    asm volatile("s_waitcnt vmcnt(0)" ::: "memory");
    __syncthreads();
    if (threadIdx.x == 0) {
        unsigned* bar = b.bar;
        __builtin_amdgcn_s_waitcnt(0);
        unsigned nloc = b.st[0], nx = b.st[1];
        if (nloc == 0u) { xcd_barrier_complete(bar, b.x, nloc, nx); b.st[0] = nloc; b.st[1] = nx; }
        const unsigned old = xb_add(&bar[XB_XSUB(b.x)], 1u);
        const unsigned gen = old / nloc;
        if (old + 1u == (gen + 1u) * nloc) {
            __builtin_amdgcn_fence(__ATOMIC_RELEASE, "agent");
            asm volatile("s_waitcnt vmcnt(0)" ::: "memory");
            const unsigned og = xb_add(&bar[XB_TOP], 1u);
            const unsigned tg = og / nx;
            if (og + 1u == (tg + 1u) * nx) xb_add(&bar[XB_TOPGEN], 1u);
            else XB_SPIN(xb_ld(&bar[XB_TOPGEN]) == tg, bar);
            __builtin_amdgcn_fence(__ATOMIC_ACQUIRE, "agent");
            xb_add(&bar[XB_XGEN(b.x)], 1u);
            asm volatile("s_waitcnt vmcnt(0)" ::: "memory");
        } else {
            XB_SPIN(xb_ld(&bar[XB_XGEN(b.x)]) == gen, bar);
            __builtin_amdgcn_fence(__ATOMIC_ACQUIRE, "agent");
            asm volatile("s_waitcnt vmcnt(0)" ::: "memory");
        }
    }
    __syncthreads();
}

struct Args { const float* in[22]; float* out; unsigned char* ws; int ph_lo, ph_hi; };
struct Frame {
    LAS unsigned char* lds;
    volatile LAS unsigned* MISC;
    gu32* ctl;
    unsigned char* ws;
    int tid, lane, wave;
    int vcu, G;
    float* out;
};

__device__ __forceinline__ float wave_sum(float v) {
#pragma unroll
    for (int o = 1; o < 64; o <<= 1) v += __shfl_xor(v, o);
    return v;
}
__device__ __forceinline__ float wave_max(float v) {
#pragma unroll
    for (int o = 1; o < 64; o <<= 1) v = fmaxf(v, __shfl_xor(v, o));
    return v;
}

template <int MODE>
__device__ __forceinline__ void p0_transpose_item(const float* W, int K, int N, bf16* WT, int row_off, LAS float* scr, int item, int lane) {
    const int nblk = N / 32, kb = item / nblk, nb = item % nblk, k0 = 64 * kb, n0 = 32 * nb;
#pragma unroll 8
    for (int i = 0; i < 32; ++i) { const int kk = 2 * i + (lane >> 5); scr[kk * 33 + (lane & 31)] = W[(size_t)(k0 + kk) * N + n0 + (lane & 31)]; }
    LDS_WAIT(); asm volatile("" ::: "memory");
    const int c = lane & 7;
#pragma unroll
    for (int j = 0; j < 4; ++j) { const int n = (lane >> 3) + 8 * j; const LAS float* s = scr + (8 * c) * 33 + n;
        v4u o; o.x = pk2(s[0 * 33], s[1 * 33]); o.y = pk2(s[2 * 33], s[3 * 33]); o.z = pk2(s[4 * 33], s[5 * 33]); o.w = pk2(s[6 * 33], s[7 * 33]);
        const int ng = n0 + n;
        const int drow = MODE == 0 ? row_off + ng : (MODE == 1 ? 32 * (ng >> 4) + (ng & 15) : 32 * (ng >> 4) + 16 + (ng & 15));
        *(GAS v4u*)(WT + (size_t)drow * K + k0 + 8 * c) = o; }
    LDS_WAIT(); asm volatile("" ::: "memory");
}

__device__ __forceinline__ void p0_prologue(Frame& F, const Args& A) {
    {
        LAS float* cact = (LAS float*)(F.lds + RING_OFF);
        LAS float* part = cact + 2048;
        for (int i = F.tid; i < 2 * D; i += NWAVES * 64) { const float cv = A.in[1][i]; cact[i] = cv / (1.0f + __expf(-cv)); }
        __syncthreads();
        for (int ch = blockIdx.x; ch < (NMOD * D) / 64; ch += F.G) {
            const int n0 = ch * 64; float a0 = 0.f, a1 = 0.f;
            const float* wp = A.in[2] + (size_t)(F.wave * 128) * (NMOD * D) + n0 + F.lane;
#pragma unroll 8
            for (int k = 0; k < 128; ++k) { const float w = wp[(size_t)k * (NMOD * D)]; a0 += cact[F.wave * 128 + k] * w; a1 += cact[D + F.wave * 128 + k] * w; }
            part[(F.wave * 2 + 0) * 64 + F.lane] = a0; part[(F.wave * 2 + 1) * 64 + F.lane] = a1;
            __syncthreads();
            if (F.tid < 128) { const int b = F.tid >> 6, l = F.tid & 63; float s = 0.f;
#pragma unroll
                for (int w = 0; w < 8; ++w) s += part[(w * 2 + b) * 64 + l];
                ((float*)(F.ws + WS_MOD))[b * (NMOD * D) + n0 + l] = s + A.in[3][n0 + l]; }
            __syncthreads();
        }
        __syncthreads();
    }
    LAS float* scr = (LAS float*)(F.lds + RING_OFF + F.wave * 16384);
    const int gw = F.vcu * NWAVES + F.wave, NGW = F.G * NWAVES;
    constexpr int I_IN = (D / 64) * (INW / 32), I_BA = (AW / 64) * (D / 32), I_BP = (PW / 64) * (D / 32), I_OUT = (D / 64) * (D / 32);
    constexpr int I_EG = (D / 64) * (DE / 32), I_ED = (DE / 64) * (D / 32);
    constexpr int NITEMS = I_IN + I_BA + I_BP + I_OUT + NE * (2 * I_EG + I_ED);
    bf16* WinT = (bf16*)(F.ws + WS_WIN); bf16* WbaT = (bf16*)(F.ws + WS_WBA); bf16* WbpT = (bf16*)(F.ws + WS_WBP); bf16* WoutT = (bf16*)(F.ws + WS_WOUT);
    bf16* WguT = (bf16*)(F.ws + WS_WGU); bf16* WdT = (bf16*)(F.ws + WS_WD);
    for (int it = gw; it < NITEMS; it += NGW) {
        int r = it;
        if (r < I_IN) { p0_transpose_item<0>(A.in[5], D, INW, WinT, 0, scr, r, F.lane); continue; } r -= I_IN;
        if (r < I_BA) { p0_transpose_item<0>(A.in[10], AW, D, WbaT, 0, scr, r, F.lane); continue; } r -= I_BA;
        if (r < I_BP) { p0_transpose_item<0>(A.in[11], PW, D, WbpT, 0, scr, r, F.lane); continue; } r -= I_BP;
        if (r < I_OUT) { p0_transpose_item<0>(A.in[12], D, D, WoutT, 0, scr, r, F.lane); continue; } r -= I_OUT;
        if (r < NE * I_EG) { const int e = r / I_EG; p0_transpose_item<1>(A.in[18] + (size_t)e * D * DE, D, DE, WguT + (size_t)e * D * D, 0, scr, r % I_EG, F.lane); continue; } r -= NE * I_EG;
        if (r < NE * I_EG) { const int e = r / I_EG; p0_transpose_item<2>(A.in[19] + (size_t)e * D * DE, D, DE, WguT + (size_t)e * D * D, 0, scr, r % I_EG, F.lane); continue; } r -= NE * I_EG;
        { const int e = r / I_ED; p0_transpose_item<0>(A.in[20] + (size_t)e * DE * D, DE, D, WdT + (size_t)e * D * DE, 0, scr, r % I_ED, F.lane); }
    }
}

__device__ __forceinline__ void p1_hrows(Frame& F, const Args& A) {
    const int gw = F.vcu * NWAVES + F.wave, NGW = F.G * NWAVES;
    const float* mod = (const float*)(F.ws + WS_MOD); bf16* H = (bf16*)(F.ws + WS_H);
    for (int m = gw; m < NTOK; m += NGW) {
        const float* md = mod + (m / SEQ) * (NMOD * D);
        const f32x4* xr = (const f32x4*)(A.in[0] + (size_t)m * D) + F.lane;
        f32x4 v[4]; float ss = 0.f;
#pragma unroll
        for (int j = 0; j < 4; ++j) { v[j] = xr[64 * j]; ss += (v[j].x * v[j].x + v[j].y * v[j].y) + (v[j].z * v[j].z + v[j].w * v[j].w); }
        const float rstd = 1.0f / sqrtf(wave_sum(ss) * (1.0f / D) + EPS);
#pragma unroll
        for (int j = 0; j < 4; ++j) { const int col = 4 * F.lane + 256 * j;
            const f32x4 g = *(const f32x4*)(A.in[4] + col), sh = *(const f32x4*)(md + col), sc = *(const f32x4*)(md + D + col);
            const f32x4 hh = (v[j] * rstd) * g * (sc + 1.0f) + sh;
            v2u o; o.x = pk2(hh.x, hh.y); o.y = pk2(hh.z, hh.w);
            *(v2u*)(H + (size_t)m * D + col) = o; }
    }
}

__device__ __forceinline__ void p3_kmean_pool(Frame& F, const Args& A) {
    const int gw = F.vcu * NWAVES + F.wave, NGW = F.G * NWAVES;
    const bf16* Kt = (const bf16*)(F.ws + WS_PROJ) + (size_t)1 * NTOK * 512;
    const bf16* Ut = (const bf16*)(F.ws + WS_PROJ) + (size_t)3 * NTOK * 512;
    float* kmean = (float*)(F.ws + WS_KMEAN);
    bf16* PO = (bf16*)(F.ws + WS_PO);
    for (int it = gw; it < BATCH * NBLK * NH; it += NGW) {
        const int h = it & 7, j = (it >> 3) & 31, b = it >> 8;
        const bf16* kp = Kt + (size_t)(b * SEQ + j * MBLK) * 512 + h * HD + F.lane; float s = 0.f;
#pragma unroll 8
        for (int r = 0; r < MBLK; ++r) s += bf2f(kp[(size_t)r * 512]);
        kmean[((b * NH + h) * NBLK + j) * HD + F.lane] = s * (1.0f / MBLK);
    }
    LAS float* dsc = (LAS float*)(F.lds + RING_OFF + F.wave * 8192);
    for (int it = gw; it < (NTOK / 8) * 4; it += NGW) {
        const int g = it & 3, m0 = (it >> 2) * 8, w = 2 << g;
#pragma unroll
        for (int r = 0; r < 8; ++r) { const int m = m0 + r, t = m & (SEQ - 1); const int lo = (t + 1 - w) > 0 ? (t + 1 - w) : 0; const int cnt = t + 1 - lo;
#pragma unroll
            for (int cc = 0; cc < 2; ++cc) { const int c = g * PGW + F.lane + 64 * cc; float s = 0.f;
                for (int k = 0; k < cnt; ++k) s += bf2f(Ut[(size_t)(m - k) * 512 + c]);
                dsc[r * 128 + F.lane + 64 * cc] = s / (float)cnt - bf2f(Ut[(size_t)m * 512 + c]); } }
        LDS_WAIT(); asm volatile("" ::: "memory");
        float acc[8][2];
#pragma unroll
        for (int r = 0; r < 8; ++r) { acc[r][0] = 0.f; acc[r][1] = 0.f; }
        const float* pw = A.in[8] + (size_t)g * PGW * PGW + F.lane;
#pragma unroll 4
        for (int c = 0; c < PGW; ++c) { const float w0 = pw[c * PGW], w1 = pw[c * PGW + 64];
#pragma unroll
            for (int r = 0; r < 8; ++r) { const float dv = dsc[r * 128 + c]; acc[r][0] += dv * w0; acc[r][1] += dv * w1; } }
        const float s0 = A.in[9][g * PGW + F.lane], s1 = A.in[9][g * PGW + F.lane + 64];
#pragma unroll
        for (int r = 0; r < 8; ++r) { PO[(size_t)(m0 + r) * 512 + g * PGW + F.lane] = (bf16)f2bf(acc[r][0] * s0); PO[(size_t)(m0 + r) * 512 + g * PGW + F.lane + 64] = (bf16)f2bf(acc[r][1] * s1); }
        LDS_WAIT(); asm volatile("" ::: "memory");
    }
}

__device__ __forceinline__ void build_btab(Frame& F, const Args& A) {
    LAS float* btab = (LAS float*)(F.lds + BTAB_OFF);
    for (int i = F.tid; i < NH * 128; i += NWAVES * 64) { const int h = i >> 7, rel = i & 127; int bk;
        if (rel < 16) bk = rel;
        else { bk = 16; const int th[15] = {19, 21, 24, 27, 31, 35, 40, 46, 52, 59, 67, 77, 87, 99, 113};
#pragma unroll
            for (int q = 0; q < 15; ++q) bk += (rel >= th[q]) ? 1 : 0; }
        btab[i] = A.in[7][bk * NH + h]; }
    __syncthreads();
}

__device__ __forceinline__ void p4_attn_naive(Frame& F, const Args& A) {
    build_btab(F, A);
    const int gw = F.vcu * NWAVES + F.wave, NGW = F.G * NWAVES;
    const bf16* Qt = (const bf16*)(F.ws + WS_PROJ);
    const bf16* Kt = Qt + (size_t)1 * NTOK * 512;
    const bf16* Vt = Qt + (size_t)2 * NTOK * 512;
    const float* kmean = (const float*)(F.ws + WS_KMEAN);
    bf16* AO = (bf16*)(F.ws + WS_AO);
    const LAS float* btab = (const LAS float*)(F.lds + BTAB_OFF);
    LAS float* qs = (LAS float*)(F.lds + RING_OFF + F.wave * 8192);
    LAS float* ps = qs + 64;
    const int lane = F.lane;
    for (int it = gw; it < NTOK * NH; it += NGW) {
        const int h = it & 7, m = it >> 3, b = m / SEQ, t = m & (SEQ - 1), blk = t >> 8;
        qs[lane] = bf2f(Qt[(size_t)m * 512 + h * HD + lane]);
        LDS_WAIT(); asm volatile("" ::: "memory");
        float q[64];
#pragma unroll
        for (int d4 = 0; d4 < 16; ++d4) { const f32x4 v = *(const LAS f32x4*)(qs + 4 * d4); q[4 * d4] = v.x; q[4 * d4 + 1] = v.y; q[4 * d4 + 2] = v.z; q[4 * d4 + 3] = v.w; }
        float sc = -3.0e38f;
        if (lane < blk) { const f32x4* km = (const f32x4*)(kmean + (size_t)((b * NH + h) * NBLK + lane) * HD); float s = 0.f;
#pragma unroll
            for (int d4 = 0; d4 < 16; ++d4) { const f32x4 kv = km[d4]; s += q[4 * d4] * kv.x + q[4 * d4 + 1] * kv.y + q[4 * d4 + 2] * kv.z + q[4 * d4 + 3] * kv.w; }
            sc = s; }
        int sel[3];
#pragma unroll
        for (int i = 0; i < 3; ++i) { const float mx = wave_max(sc); const unsigned long long mk = __ballot(sc == mx && lane < blk);
            const int idx = mk ? (int)__builtin_ctzll(mk) : 0; sel[i] = idx; if (lane == idx) sc = -3.0e38f; }
        const int nsel = blk < 3 ? blk : 3;
        float lg[4][4];
#pragma unroll
        for (int s = 0; s < 4; ++s) {
            const bool valid = (s == 3) || (s < nsel);
            const int jb = (s == 3) ? blk : sel[s < 3 ? s : 0];
#pragma unroll
            for (int i = 0; i < 4; ++i) {
                float lgt = NEG_INF;
                if (valid) { const int kk = lane + 64 * i, kpos = jb * MBLK + kk;
                    const v4u* kr = (const v4u*)(Kt + (size_t)(b * SEQ + kpos) * 512 + h * HD); float dsum = 0.f;
#pragma unroll
                    for (int c8 = 0; c8 < 8; ++c8) { const v4u kv = kr[c8];
                        dsum += q[8 * c8 + 0] * __uint_as_float(kv.x << 16) + q[8 * c8 + 1] * __uint_as_float(kv.x & 0xffff0000u)
                              + q[8 * c8 + 2] * __uint_as_float(kv.y << 16) + q[8 * c8 + 3] * __uint_as_float(kv.y & 0xffff0000u)
                              + q[8 * c8 + 4] * __uint_as_float(kv.z << 16) + q[8 * c8 + 5] * __uint_as_float(kv.z & 0xffff0000u)
                              + q[8 * c8 + 6] * __uint_as_float(kv.w << 16) + q[8 * c8 + 7] * __uint_as_float(kv.w & 0xffff0000u); }
                    const int rel = t - kpos;
                    if (rel >= 0) lgt = dsum * 0.125f + btab[h * 128 + (rel > 127 ? 127 : rel)]; }
                lg[s][i] = lgt; }
        }
        float mx = NEG_INF;
#pragma unroll
        for (int s = 0; s < 4; ++s)
#pragma unroll
            for (int i = 0; i < 4; ++i) mx = fmaxf(mx, lg[s][i]);
        mx = wave_max(mx);
        float sum = 0.f;
#pragma unroll
        for (int s = 0; s < 4; ++s)
#pragma unroll
            for (int i = 0; i < 4; ++i) { const float e = (lg[s][i] <= -1e29f) ? 0.f : __expf(lg[s][i] - mx); lg[s][i] = e; sum += e; }
        sum = wave_sum(sum);
        const float inv = 1.0f / sum;
#pragma unroll
        for (int s = 0; s < 4; ++s)
#pragma unroll
            for (int i = 0; i < 4; ++i) ps[s * 256 + lane + 64 * i] = lg[s][i] * inv;
        LDS_WAIT(); asm volatile("" ::: "memory");
        float o = 0.f;
#pragma unroll
        for (int s = 0; s < 4; ++s) {
            const bool valid = (s == 3) || (s < nsel);
            if (valid) { const int jb = (s == 3) ? blk : sel[s < 3 ? s : 0];
                const int nk = (s == 3) ? (((t & 255) + 4) & ~3) : 256;
                const bf16* vp = Vt + (size_t)(b * SEQ + jb * MBLK) * 512 + h * HD + lane;
                for (int kk = 0; kk < nk; kk += 4) { const f32x4 p4 = *(const LAS f32x4*)(ps + s * 256 + kk);
                    o += p4.x * bf2f(vp[(size_t)(kk + 0) * 512]) + p4.y * bf2f(vp[(size_t)(kk + 1) * 512]) + p4.z * bf2f(vp[(size_t)(kk + 2) * 512]) + p4.w * bf2f(vp[(size_t)(kk + 3) * 512]); } }
        }
        AO[(size_t)m * 512 + h * HD + lane] = (bf16)f2bf(o);
        LDS_WAIT(); asm volatile("" ::: "memory");
    }
}

__device__ __forceinline__ void p7_norm_route(Frame& F, const Args& A) {
    const int gw = F.vcu * NWAVES + F.wave, NGW = F.G * NWAVES, lane = F.lane;
    const float* mod = (const float*)(F.ws + WS_MOD); bf16* H2 = (bf16*)(F.ws + WS_H);
    int* route = (int*)(F.ws + WS_ROUTE); int* list = (int*)(F.ws + WS_LIST);
    LAS float* hs = (LAS float*)(F.lds + RING_OFF + F.wave * 16384);
    const float* w_rg = A.in[14]; const float* w_re = A.in[16];
    const float* wcol = lane < 32 ? w_re + lane : w_rg + ((lane - 32) & 3);
    const int wstride = lane < 32 ? NE : 4;
    const float bias = lane < 32 ? A.in[17][lane] : A.in[15][(lane - 32) & 3];
    for (int m0 = gw * 4; m0 < NTOK; m0 += NGW * 4) {
        const float* md = mod + (m0 / SEQ) * (NMOD * D);
#pragma unroll
        for (int r = 0; r < 4; ++r) { const int m = m0 + r;
            const f32x4* xr = (const f32x4*)(F.out + (size_t)m * D) + lane;
            f32x4 v[4]; float ss = 0.f;
#pragma unroll
            for (int j = 0; j < 4; ++j) { v[j] = xr[64 * j]; ss += (v[j].x * v[j].x + v[j].y * v[j].y) + (v[j].z * v[j].z + v[j].w * v[j].w); }
            const float rstd = 1.0f / sqrtf(wave_sum(ss) * (1.0f / D) + EPS);
#pragma unroll
            for (int j = 0; j < 4; ++j) { const int col = 4 * lane + 256 * j;
                const f32x4 g = *(const f32x4*)(A.in[13] + col), sh = *(const f32x4*)(md + 3 * D + col), sc = *(const f32x4*)(md + 4 * D + col);
                const f32x4 hh = (v[j] * rstd) * g * (sc + 1.0f) + sh;
                v2u o; o.x = pk2(hh.x, hh.y); o.y = pk2(hh.z, hh.w);
                *(v2u*)(H2 + (size_t)m * D + col) = o;
                *(LAS f32x4*)(hs + r * 1024 + col) = hh; }
        }
        LDS_WAIT(); asm volatile("" ::: "memory");
        float z0 = 0.f, z1 = 0.f, z2 = 0.f, z3 = 0.f;
#pragma unroll 2
        for (int c = 0; c < D; c += 4) {
            const float wa = wcol[(size_t)(c + 0) * wstride], wb = wcol[(size_t)(c + 1) * wstride], wc_ = wcol[(size_t)(c + 2) * wstride], wd = wcol[(size_t)(c + 3) * wstride];
            const f32x4 h0 = *(const LAS f32x4*)(hs + c), h1 = *(const LAS f32x4*)(hs + 1024 + c), h2v = *(const LAS f32x4*)(hs + 2048 + c), h3 = *(const LAS f32x4*)(hs + 3072 + c);
            z0 += h0.x * wa + h0.y * wb + h0.z * wc_ + h0.w * wd;
            z1 += h1.x * wa + h1.y * wb + h1.z * wc_ + h1.w * wd;
            z2 += h2v.x * wa + h2v.y * wb + h2v.z * wc_ + h2v.w * wd;
            z3 += h3.x * wa + h3.y * wb + h3.z * wc_ + h3.w * wd;
        }
#pragma unroll
        for (int r = 0; r < 4; ++r) { const int m = m0 + r;
            const float z = (r == 0 ? z0 : (r == 1 ? z1 : (r == 2 ? z2 : z3))) + bias;
            const bool isg = lane >= 32 && lane < 36;
            const float vg = isg ? z : -3.0e38f;
            const float gm = wave_max(vg);
            const int gi = (int)__builtin_ctzll(__ballot(isg && vg == gm)) - 32;
            const float gs = wave_sum(isg ? __expf(vg - gm) : 0.f);
            const float pg = 1.0f / gs;
            const bool ing = lane < 32 && (lane >> 3) == gi;
            const float ve = ing ? z : -3.0e38f;
            const float e0m = wave_max(ve);
            const int ex0 = (int)__builtin_ctzll(__ballot(ing && ve == e0m));
            const float ve2 = (lane == ex0) ? -3.0e38f : ve;
            const float e1m = wave_max(ve2);
            const int ex1 = (int)__builtin_ctzll(__ballot(ing && lane != ex0 && ve2 == e1m));
            const float e1 = __expf(e1m - e0m); const float w0 = pg / (1.0f + e1), w1 = pg * e1 / (1.0f + e1);
            if (lane == 0) {
                const int p0 = (int)__hip_atomic_fetch_add((unsigned*)(F.ctl + CW_ECNT + 64 * ex0), 1u, RLX_AGENT);
                const int p1 = (int)__hip_atomic_fetch_add((unsigned*)(F.ctl + CW_ECNT + 64 * ex1), 1u, RLX_AGENT);
                list[(size_t)ex0 * NTOK + p0] = m; list[(size_t)ex1 * NTOK + p1] = m;
                int* rt = route + (size_t)m * 8; rt[0] = ex0; rt[1] = ex1; rt[2] = p0; rt[3] = p1; rt[4] = __float_as_int(w0); rt[5] = __float_as_int(w1);
            }
        }
        LDS_WAIT(); asm volatile("" ::: "memory");
    }
}

__device__ __forceinline__ void build_tables(Frame& F) {
    LAS int* toff = (LAS int*)(F.lds + TOFF_OFF); LAS int* ecnt = (LAS int*)(F.lds + ECNT_OFF); LAS int* tile_e = (LAS int*)(F.lds + TILEE_OFF);
    __syncthreads();
    if (F.tid < NE) ecnt[F.tid] = (int)__hip_atomic_load((unsigned*)(F.ctl + CW_ECNT + 64 * F.tid), RLX_AGENT);
    __syncthreads();
    if (F.tid == 0) { int o = 0; for (int e = 0; e < NE; ++e) { toff[e] = o; const int nt = (ecnt[e] + 255) >> 8; for (int k = 0; k < nt; ++k) tile_e[o + k] = e; o += nt; } toff[NE] = o; }
    __syncthreads();
}

__device__ __forceinline__ void p8_gather(Frame& F, const Args& A) {
    build_tables(F);
    const int gw = F.vcu * NWAVES + F.wave, NGW = F.G * NWAVES;
    const LAS int* toff = (const LAS int*)(F.lds + TOFF_OFF); const LAS int* ecnt = (const LAS int*)(F.lds + ECNT_OFF); const LAS int* tile_e = (const LAS int*)(F.lds + TILEE_OFF);
    const bf16* H2 = (const bf16*)(F.ws + WS_H); bf16* XG = (bf16*)(F.ws + WS_XG); const int* list = (const int*)(F.ws + WS_LIST);
    const int nrows = toff[NE] * 256;
    for (int r = gw; r < nrows; r += NGW) {
        const int e = tile_e[r >> 8], p = r - toff[e] * 256;
        v4u a = (v4u){0u, 0u, 0u, 0u}, bq = a;
        if (p < ecnt[e]) { const int tok = list[(size_t)e * NTOK + p]; const v4u* src = (const v4u*)(H2 + (size_t)tok * D); a = src[F.lane]; bq = src[F.lane + 64]; }
        v4u* dst = (v4u*)(XG + (size_t)r * D); dst[F.lane] = a; dst[F.lane + 64] = bq;
    }
}

__device__ __forceinline__ void p11_final(Frame& F, const Args& A) {
    build_tables(F);
    const int gw = F.vcu * NWAVES + F.wave, NGW = F.G * NWAVES;
    const LAS int* toff = (const LAS int*)(F.lds + TOFF_OFF);
    const float* mod = (const float*)(F.ws + WS_MOD); const bf16* Y = (const bf16*)(F.ws + WS_Y); const int* route = (const int*)(F.ws + WS_ROUTE);
    for (int m = gw; m < NTOK; m += NGW) {
        const float* md = mod + (m / SEQ) * (NMOD * D);
        const int* rt = route + (size_t)m * 8;
        const int e0 = rt[0], e1 = rt[1], p0 = rt[2], p1 = rt[3]; const float w0 = __int_as_float(rt[4]), w1 = __int_as_float(rt[5]);
        const size_t r0 = (size_t)toff[e0] * 256 + p0, r1 = (size_t)toff[e1] * 256 + p1;
        f32x4* xr = (f32x4*)(F.out + (size_t)m * D) + F.lane;
        f32x4 v[4]; float ss = 0.f;
#pragma unroll
        for (int j = 0; j < 4; ++j) { const int col = 4 * F.lane + 256 * j;
            const v2u y0 = *(const v2u*)(Y + r0 * D + col), y1 = *(const v2u*)(Y + r1 * D + col);
            const f32x4 g2 = *(const f32x4*)(md + 5 * D + col);
            f32x4 yy; yy.x = w0 * __uint_as_float(y0.x << 16) + w1 * __uint_as_float(y1.x << 16); yy.y = w0 * __uint_as_float(y0.x & 0xffff0000u) + w1 * __uint_as_float(y1.x & 0xffff0000u);
            yy.z = w0 * __uint_as_float(y0.y << 16) + w1 * __uint_as_float(y1.y << 16); yy.w = w0 * __uint_as_float(y0.y & 0xffff0000u) + w1 * __uint_as_float(y1.y & 0xffff0000u);
            v[j] = xr[64 * j] + g2 * yy;
            ss += (v[j].x * v[j].x + v[j].y * v[j].y) + (v[j].z * v[j].z + v[j].w * v[j].w); }
        const float rstd = 1.0f / sqrtf(wave_sum(ss) * (1.0f / D) + EPS);
#pragma unroll
        for (int j = 0; j < 4; ++j) { const int col = 4 * F.lane + 256 * j; const f32x4 g = *(const f32x4*)(A.in[21] + col); xr[64 * j] = (v[j] * rstd) * g; }
    }
}

__global__ void __launch_bounds__(NWAVES * 64, 2) mk_fwd(Args args) {
    extern __shared__ __attribute__((aligned(16))) unsigned char lds[];
    Frame F;
    F.lds = (LAS unsigned char*)lds;
    F.MISC = (volatile LAS unsigned*)(F.lds + MISC_OFF);
    F.tid = threadIdx.x; F.lane = F.tid & 63; F.wave = __builtin_amdgcn_readfirstlane(F.tid >> 6);
    F.G = gridDim.x; { const int bx = blockIdx.x; F.vcu = (F.G % 8 == 0) ? (bx % 8) * (F.G / 8) + bx / 8 : bx; }
    F.ws = args.ws; F.ctl = (gu32*)(args.ws + WS_CTL); F.out = args.out;
    for (int u = F.tid; u < (LDS_BYTES - LDSCTL_OFF) / 4; u += NWAVES * 64) ((LAS unsigned*)(F.lds + LDSCTL_OFF))[u] = 0u;
    __syncthreads();
    XcdBarrier bar; bar.bar = (unsigned*)(F.ctl + CW_BAR); bar.x = 0; bar.st = nullptr;
    if (N_LAUNCHES != PER_PHASE) bar = xcd_barrier_post((unsigned*)(F.ctl + CW_BAR), F.MISC + 8);
#define GRID_BAR(seam) do { if (N_LAUNCHES == PER_PHASE) { if (F.tid == 0) __hip_atomic_store(F.ctl + CW_TMO, 0xBADBA0u | (unsigned)(seam), RLX_AGENT); } else { xcd_barrier(bar); } } while (0)
    const int lo = args.ph_lo, hi = args.ph_hi;
#define IN(k) (lo <= (k) && (k) < hi)
#define BOTH(k) (IN(k) && IN((k) + 1))
    bf16* PROJ = (bf16*)(F.ws + WS_PROJ);

    if (IN(0)) { p0_prologue(F, args); if (BOTH(0)) GRID_BAR(0); }
    if (IN(1)) { p1_hrows(F, args); if (BOTH(1)) GRID_BAR(1); }
    if (IN(2)) {
        pg8::Gemm g{(const bf16*)(F.ws + WS_H), (const bf16*)(F.ws + WS_WIN), NTOK, INW, D, 0};
        pg8::StaticOrder S; S.init(NTOK, INW, F.G, (int)blockIdx.x);
        pg8::EpiProj E{PROJ, args.in[6]};
        pg8::gemm_phase<pg8::EpiProj, pg8::StaticOrder, true, true>(F.lds + RING_OFF, g, S, E);
        if (BOTH(2)) GRID_BAR(2);
    }
    if (IN(3)) { p3_kmean_pool(F, args); if (BOTH(3)) GRID_BAR(3); }
    if (IN(4)) { p4_attn_naive(F, args); if (BOTH(4)) GRID_BAR(4); }
    if (IN(5)) {
        bf16* T = (bf16*)(F.ws + WS_T);
        { pg8::Gemm g{(const bf16*)(F.ws + WS_AO), (const bf16*)(F.ws + WS_WBA), NTOK, D, AW, 0};
          pg8::StaticOrder S; S.init(NTOK, D, F.G, (int)blockIdx.x);
          pg8::EpiGate<false> E{PROJ + (size_t)4 * NTOK * 512, T};
          pg8::gemm_phase<pg8::EpiGate<false>, pg8::StaticOrder, false, true>(F.lds + RING_OFF, g, S, E); }
        VM_WAIT(); __syncthreads();
        { pg8::Gemm g{(const bf16*)(F.ws + WS_PO), (const bf16*)(F.ws + WS_WBP), NTOK, D, PW, 0};
          pg8::StaticOrder S; S.init(NTOK, D, F.G, (int)blockIdx.x);
          pg8::EpiGate<true> E{PROJ + (size_t)6 * NTOK * 512, T};
          pg8::gemm_phase<pg8::EpiGate<true>, pg8::StaticOrder, false, true>(F.lds + RING_OFF, g, S, E); }
        if (BOTH(5)) GRID_BAR(5);
    }
    if (IN(6)) {
        pg8::Gemm g{(const bf16*)(F.ws + WS_T), (const bf16*)(F.ws + WS_WOUT), NTOK, D, D, 0};
        pg8::StaticOrder S; S.init(NTOK, D, F.G, (int)blockIdx.x);
        pg8::EpiRes E{args.in[0], F.out, (const float*)(F.ws + WS_MOD)};
        pg8::gemm_phase<pg8::EpiRes, pg8::StaticOrder, false, true>(F.lds + RING_OFF, g, S, E);
        if (BOTH(6)) GRID_BAR(6);
    }
    if (IN(7)) { p7_norm_route(F, args); if (BOTH(7)) GRID_BAR(7); }
    if (IN(8)) { p8_gather(F, args); if (BOTH(8)) GRID_BAR(8); }
    if (IN(9)) {
        build_tables(F);
        const int ntiles = ((const LAS int*)(F.lds + TOFF_OFF))[NE];
        pg8::Gemm g{(const bf16*)(F.ws + WS_XG), (const bf16*)(F.ws + WS_WGU), ntiles * 256, D, D, (size_t)D * D * 2};
        pg8::GroupedOrder S; S.so.init(ntiles * 256, D, F.G, (int)blockIdx.x); S.tile_e = (const LAS int*)(F.lds + TILEE_OFF);
        pg8::EpiSwiglu E{(bf16*)(F.ws + WS_ACT)};
        pg8::gemm_phase<pg8::EpiSwiglu, pg8::GroupedOrder, true, true>(F.lds + RING_OFF, g, S, E);
        if (BOTH(9)) GRID_BAR(9);
    }
    if (IN(10)) {
        build_tables(F);
        const int ntiles = ((const LAS int*)(F.lds + TOFF_OFF))[NE];
        pg8::Gemm g{(const bf16*)(F.ws + WS_ACT), (const bf16*)(F.ws + WS_WD), ntiles * 256, D, DE, (size_t)D * DE * 2};
        pg8::GroupedOrder S; S.so.init(ntiles * 256, D, F.G, (int)blockIdx.x); S.tile_e = (const LAS int*)(F.lds + TILEE_OFF);
        pg8::EpiY E{(bf16*)(F.ws + WS_Y)};
        pg8::gemm_phase<pg8::EpiY, pg8::GroupedOrder, true, true>(F.lds + RING_OFF, g, S, E);
        if (BOTH(10)) GRID_BAR(10);
    }
    if (IN(11)) { p11_final(F, args); }
#undef IN
#undef BOTH
}

extern "C" void kernel_launch(void* const* d_in, const int* in_sizes, int n_in, void* d_out, int out_size, void* d_ws, size_t ws_size, hipStream_t stream) {
    static int grid = 0;
    if (grid == 0) {
        if (n_in != 22 || in_sizes[0] != NTOK * D || out_size != NTOK * D || ws_size < WS_END) { fprintf(stderr, "kernel_launch: unexpected shapes (n_in %d, in0 %d, out %d, ws %zu); nothing launched\n", n_in, n_in > 0 ? in_sizes[0] : -1, out_size, ws_size); grid = -1; return; }
        int dev = 0, cus = 0, per_cu = 0;
        if (hipGetDevice(&dev) != hipSuccess || hipDeviceGetAttribute(&cus, hipDeviceAttributeMultiprocessorCount, dev) != hipSuccess) { fprintf(stderr, "kernel_launch: device query failed\n"); grid = -1; return; }
        if (hipFuncSetAttribute((const void*)mk_fwd, hipFuncAttributeMaxDynamicSharedMemorySize, LDS_BYTES) != hipSuccess) { fprintf(stderr, "kernel_launch: hipFuncSetAttribute failed\n"); grid = -1; return; }
        if (hipOccupancyMaxActiveBlocksPerMultiprocessor(&per_cu, (const void*)mk_fwd, NWAVES * 64, LDS_BYTES) != hipSuccess || per_cu < 1)
            fprintf(stderr, "kernel_launch: note: occupancy query reports %d workgroups per CU\n", per_cu);
        (void)hipGetLastError();
        grid = cus;
    }
    if (grid < 0) return;
    if (hipMemsetAsync((char*)d_ws + WS_CTL, 0, CTL_ZERO_BYTES, stream) != hipSuccess) { fprintf(stderr, "kernel_launch: memset failed\n"); return; }
    Args a{};
    for (int i = 0; i < 22; ++i) a.in[i] = (const float*)d_in[i];
    a.out = (float*)d_out; a.ws = (unsigned char*)d_ws;
    if (N_LAUNCHES == 1) { a.ph_lo = 0; a.ph_hi = PER_PHASE; hipLaunchKernelGGL(mk_fwd, dim3(grid), dim3(NWAVES * 64), LDS_BYTES, stream, a); }
    else for (int li = 0; li < PER_PHASE; ++li) { a.ph_lo = li; a.ph_hi = li + 1; hipLaunchKernelGGL(mk_fwd, dim3(grid), dim3(NWAVES * 64), LDS_BYTES, stream, a); }
}
```

```cpp
#include <hip/hip_runtime.h>
#include <cstdio>
#include <cstdint>

constexpr int BATCH = 2, SEQ = 8192, D = 1024, NTOK = BATCH * SEQ;
constexpr int NH = 8, HD = 64, AW = 512, MBLK = 256, NBLK = SEQ / MBLK;
constexpr int PW = 512, PGW = 128;
constexpr int INW = 4096;
constexpr int NE = 32, DE = 512;
constexpr int NMOD = 6;
constexpr int MAXTILES = 160;
constexpr float EPS = 1e-6f;
constexpr float NEG_INF = -1e30f;

namespace pg8 {
#define PG8_LAS __attribute__((address_space(3)))
typedef unsigned short bf16_t;
typedef short bf16x8 __attribute__((ext_vector_type(8)));
typedef float f32x4 __attribute__((ext_vector_type(4)));
typedef unsigned u32x4 __attribute__((ext_vector_type(4)));
typedef unsigned u32x2 __attribute__((ext_vector_type(2)));
constexpr int BM = 256, BK = 64, HALF = 128, HTB = HALF * BK * 2  , STAGE_BYTES = 8 * HTB, NXCD = 8, WGM = 8;

__host__ __device__ __forceinline__ int lds_byte(int r, int c) { const int st = (r >> 4) * 2 + (c >> 5), rr = r & 15, cc = c & 31, ob = rr * 64 + cc * 2; return st * 1024 + (ob ^ (((ob >> 9) & 1) << 5)); }
__host__ __device__ __forceinline__ void stage_rc(int b, int& R, int& C) { const int st = b / 1024, sb = b % 1024, swz = sb ^ (((sb >> 9) & 1) << 5); R = (st >> 1) * 16 + swz / 64; C = (st & 1) * 32 + (swz % 64) / 2; }
__host__ __device__ __forceinline__ int perm32(int rho) { const int n = rho >> 4, i = rho & 15; return 8 * (i >> 2) + 4 * n + (i & 3); }

struct Unit { int pm, pn, e; };
struct Gemm { const bf16_t* A; const bf16_t* Bt; int M, N, K; size_t estride; };

struct StaticOrder {
    int nM, nN, nwg, G, c;
    __host__ __device__ void init(int M, int N, int G_, int c_) { nM = M / BM; nN = N / BM; nwg = nM * nN; G = G_; c = c_; }
    __host__ __device__ bool next(int i, Unit& u) const {
        const long L = (long)i * G + c; if (L >= nwg) return false;
        int wgid = (int)L; { const int q = nwg / NXCD, r = nwg % NXCD, xcd = wgid % NXCD, off = wgid / NXCD; wgid = (xcd < r ? xcd * (q + 1) : r * (q + 1) + (xcd - r) * q) + off; }
        const int nig = WGM * nN, gid = wgid / nig, fm = gid * WGM, gsz = (nM - fm) < WGM ? (nM - fm) : WGM;
        u.pm = fm + ((wgid % nig) % gsz); u.pn = (wgid % nig) / gsz; u.e = 0; return true;
    }
    __device__ __forceinline__ void a_ready(const Unit&) const {}
    __device__ __forceinline__ void done(const Unit&) const {}
};
struct GroupedOrder {
    StaticOrder so; const PG8_LAS int* tile_e;
    __device__ __forceinline__ bool next(int i, Unit& u) const {
        if (!so.next(i, u)) return false;
        u.e = __builtin_amdgcn_readfirstlane(tile_e[u.pm]); return true;
    }
    __device__ __forceinline__ void a_ready(const Unit&) const {}
    __device__ __forceinline__ void done(const Unit&) const {}
};

__device__ __forceinline__ unsigned cvt_pk_bf16(float lo, float hi) { unsigned r; asm volatile("v_cvt_pk_bf16_f32 %0, %1, %2" : "=v"(r) : "v"(lo), "v"(hi)); return r; }
__device__ __forceinline__ float bf_lo(unsigned u) { return __uint_as_float(u << 16); }
__device__ __forceinline__ float bf_hi(unsigned u) { return __uint_as_float(u & 0xffff0000u); }
__device__ __forceinline__ float sigm(float x) { return 1.0f / (1.0f + __expf(-x)); }
__device__ __forceinline__ u32x4 pack8(const f32x4 v0, const f32x4 v1) { u32x4 w; w.x = cvt_pk_bf16(v0[0], v0[1]); w.y = cvt_pk_bf16(v0[2], v0[3]); w.z = cvt_pk_bf16(v1[0], v1[1]); w.w = cvt_pk_bf16(v1[2], v1[3]); return w; }

struct EpiProj {
    static constexpr bool PERM = true, AFTER_DRAIN = false;
    bf16_t* O; const float* bgate; float* ksum;
    __device__ __forceinline__ void operator()(const f32x4 (&acc)[2][2][4][2], const Unit& u, int wr, int wc, int fr, int fq) const {
        const int t = u.pn >> 1, colt = (u.pn & 1) * 256; const bool gate = t >= 4;
        if (t == 1) {
#pragma unroll
            for (int bj = 0; bj < 2; ++bj)
#pragma unroll
                for (int n = 0; n < 2; ++n) { f32x4 s = (f32x4){0.f, 0.f, 0.f, 0.f};
#pragma unroll
                    for (int ai = 0; ai < 2; ++ai)
#pragma unroll
                        for (int m = 0; m < 4; ++m) s += acc[ai][bj][m][n];
#pragma unroll
                    for (int j = 0; j < 4; ++j) { float v = s[j]; v += __shfl_xor(v, 1); v += __shfl_xor(v, 2); v += __shfl_xor(v, 4); v += __shfl_xor(v, 8); s[j] = v; }
                    if (fr == 0) { const int c = colt + bj * HALF + wc * 32 + 8 * fq + 4 * n;
                        float* kp = ksum + (size_t)(((u.pm >> 5) * NH + (c >> 6)) * NBLK + (u.pm & 31)) * HD + (c & 63);
#pragma unroll
                        for (int j = 0; j < 4; ++j) atomicAdd(kp + j, s[j]); } }
        }
        bf16_t* base = O + (size_t)t * ((size_t)NTOK * 512);
        const int row0 = u.pm * BM + wr * 64 + fr, col0 = colt + wc * 32 + 8 * fq, bcol0 = u.pn * BM - 2048 + wc * 32 + 8 * fq;
        f32x4 bv[2][2];
#pragma unroll
        for (int bj = 0; bj < 2; ++bj)
#pragma unroll
            for (int n = 0; n < 2; ++n) bv[bj][n] = gate ? *(const f32x4*)(bgate + bcol0 + bj * HALF + 4 * n) : (f32x4){0.f, 0.f, 0.f, 0.f};
#pragma unroll
        for (int ai = 0; ai < 2; ++ai)
#pragma unroll
            for (int m = 0; m < 4; ++m) { bf16_t* rowp = base + (size_t)(row0 + ai * HALF + m * 16) * 512 + col0;
#pragma unroll
                for (int bj = 0; bj < 2; ++bj) { f32x4 v0 = acc[ai][bj][m][0] + bv[bj][0], v1 = acc[ai][bj][m][1] + bv[bj][1];
                    if (gate) {
#pragma unroll
                        for (int j = 0; j < 4; ++j) { v0[j] = sigm(v0[j]); v1[j] = sigm(v1[j]); } }
                    *(u32x4*)(rowp + bj * HALF) = pack8(v0, v1); } }
    }
};
template <bool SECOND> struct EpiGate {
    static constexpr bool PERM = true, AFTER_DRAIN = false;
    const bf16_t* G; bf16_t* T;
    __device__ __forceinline__ void operator()(const f32x4 (&acc)[2][2][4][2], const Unit& u, int wr, int wc, int fr, int fq) const {
        const bf16_t* gbase = G + (size_t)(u.pn >> 1) * ((size_t)NTOK * 512);
        const int row0 = u.pm * BM + wr * 64 + fr, gcol0 = (u.pn & 1) * 256 + wc * 32 + 8 * fq, col0 = u.pn * BM + wc * 32 + 8 * fq;
#pragma unroll
        for (int ai = 0; ai < 2; ++ai)
#pragma unroll
            for (int m = 0; m < 4; ++m) { const int r = row0 + ai * HALF + m * 16;
#pragma unroll
                for (int bj = 0; bj < 2; ++bj) {
                    const u32x4 gv = *(const u32x4*)(gbase + (size_t)r * 512 + gcol0 + bj * HALF);
                    bf16_t* tp = T + (size_t)r * 1024 + col0 + bj * HALF;
                    f32x4 v0 = acc[ai][bj][m][0] * (f32x4){bf_lo(gv.x), bf_hi(gv.x), bf_lo(gv.y), bf_hi(gv.y)};
                    f32x4 v1 = acc[ai][bj][m][1] * (f32x4){bf_lo(gv.z), bf_hi(gv.z), bf_lo(gv.w), bf_hi(gv.w)};
                    if (SECOND) { const u32x4 tv = *(const u32x4*)tp;
                        v0 += (f32x4){bf_lo(tv.x), bf_hi(tv.x), bf_lo(tv.y), bf_hi(tv.y)}; v1 += (f32x4){bf_lo(tv.z), bf_hi(tv.z), bf_lo(tv.w), bf_hi(tv.w)}; }
                    *(u32x4*)tp = pack8(v0, v1); } }
    }
};
struct EpiRes {
    static constexpr bool PERM = false, AFTER_DRAIN = false;
    const float* x; float* out; const float* mod;
    __device__ __forceinline__ void operator()(const f32x4 (&acc)[2][2][4][2], const Unit& u, int wr, int wc, int fr, int fq) const {
        const int b = (u.pm * BM) / SEQ; const float* gp = mod + b * (NMOD * D) + 2 * D;
        const int row0 = u.pm * BM + wr * 64 + fr, col0 = u.pn * BM + wc * 32 + 4 * fq;
        f32x4 gv[2][2];
#pragma unroll
        for (int bj = 0; bj < 2; ++bj)
#pragma unroll
            for (int n = 0; n < 2; ++n) gv[bj][n] = *(const f32x4*)(gp + col0 + bj * HALF + n * 16);
#pragma unroll
        for (int ai = 0; ai < 2; ++ai)
#pragma unroll
            for (int m = 0; m < 4; ++m) { const size_t off = (size_t)(row0 + ai * HALF + m * 16) * D + col0;
#pragma unroll
                for (int bj = 0; bj < 2; ++bj)
#pragma unroll
                    for (int n = 0; n < 2; ++n) { const f32x4 xs = *(const f32x4*)(x + off + bj * HALF + n * 16); *(f32x4*)(out + off + bj * HALF + n * 16) = xs + gv[bj][n] * acc[ai][bj][m][n]; } }
    }
};
struct EpiSwiglu {
    static constexpr bool PERM = false, AFTER_DRAIN = false;
    bf16_t* act;
    __device__ __forceinline__ void operator()(const f32x4 (&acc)[2][2][4][2], const Unit& u, int wr, int wc, int fr, int fq) const {
        const int row0 = u.pm * BM + wr * 64 + fr, col0 = u.pn * 128 + wc * 16 + 4 * fq;
#pragma unroll
        for (int ai = 0; ai < 2; ++ai)
#pragma unroll
            for (int m = 0; m < 4; ++m) { bf16_t* rowp = act + (size_t)(row0 + ai * HALF + m * 16) * DE + col0;
#pragma unroll
                for (int bj = 0; bj < 2; ++bj) { const f32x4 g = acc[ai][bj][m][0], up = acc[ai][bj][m][1]; f32x4 a;
#pragma unroll
                    for (int j = 0; j < 4; ++j) a[j] = g[j] * sigm(g[j]) * up[j];
                    u32x2 w; w.x = cvt_pk_bf16(a[0], a[1]); w.y = cvt_pk_bf16(a[2], a[3]);
                    *(u32x2*)(rowp + bj * 64) = w; } }
    }
};
struct EpiY {
    static constexpr bool PERM = true, AFTER_DRAIN = false;
    bf16_t* Y;
    __device__ __forceinline__ void operator()(const f32x4 (&acc)[2][2][4][2], const Unit& u, int wr, int wc, int fr, int fq) const {
        const int row0 = u.pm * BM + wr * 64 + fr, col0 = u.pn * BM + wc * 32 + 8 * fq;
#pragma unroll
        for (int ai = 0; ai < 2; ++ai)
#pragma unroll
            for (int m = 0; m < 4; ++m) { bf16_t* rowp = Y + (size_t)(row0 + ai * HALF + m * 16) * D + col0;
#pragma unroll
                for (int bj = 0; bj < 2; ++bj) *(u32x4*)(rowp + bj * HALF) = pack8(acc[ai][bj][m][0], acc[ai][bj][m][1]); }
    }
};

template <class Epi, class Sched, bool ALIGN_EPI = false, bool SP2 = false>
__device__ __forceinline__ void gemm_phase(PG8_LAS unsigned char* lds, const Gemm g, const Sched& S, const Epi& E) {
    const int tid = threadIdx.x, wid = __builtin_amdgcn_readfirstlane(tid >> 6), lane = tid & 63, wr = wid >> 2, wc = wid & 3, fr = lane & 15, fq = lane >> 4;
    const int K = g.K, nt = K / BK;
    unsigned voffA[2], voffB[2];
#pragma unroll
    for (int i = 0; i < 2; ++i) { int R, C; stage_rc(tid * 16 + i * 8192, R, C); const int Rb = Epi::PERM ? ((R & ~31) + perm32(R & 31)) : R;
        voffA[i] = (unsigned)(R * K + C) * 2u; voffB[i] = (unsigned)(Rb * K + C) * 2u; }
    const size_t kstep = (size_t)(BK * 2);
    const size_t hstep = (size_t)HALF * K * 2;
    const size_t tstep = 2 * hstep;
    const unsigned ldsw = (unsigned)wid * 1024u;
    const int aoff = lds_byte(wr * 64 + fr, fq * 8), boff = lds_byte(wc * 32 + fr, fq * 8);
#define PG8_SA(b, h) (((b) * 2 + (h)) * HTB)
#define PG8_SB(b, h) ((4 + (b) * 2 + (h)) * HTB)
#define PG8_STAGE(bufoff, gbase, voff) do { _Pragma("unroll") for (int _i = 0; _i < 2; ++_i) \
        __builtin_amdgcn_global_load_lds((const unsigned*)((const char*)(gbase) + (voff)[_i]), (PG8_LAS unsigned*)(lds + (bufoff) + ldsw + _i * 8192), 16, 0, 0); } while (0)
#define PG8_LDA(dst, b, h) do { _Pragma("unroll") for (int m = 0; m < 4; ++m) _Pragma("unroll") for (int k = 0; k < 2; ++k) dst[m][k] = *(const PG8_LAS bf16x8*)(lds + PG8_SA(b, h) + aoff + m * 2048 + k * 1024); } while (0)
#define PG8_LDB(dst, b, h) do { _Pragma("unroll") for (int n = 0; n < 2; ++n) _Pragma("unroll") for (int k = 0; k < 2; ++k) dst[n][k] = *(const PG8_LAS bf16x8*)(lds + PG8_SB(b, h) + boff + n * 2048 + k * 1024); } while (0)
#define PG8_MMA(ai, bj, At, Bt) do { __builtin_amdgcn_s_setprio(1); _Pragma("unroll") for (int m = 0; m < 4; ++m) _Pragma("unroll") for (int n = 0; n < 2; ++n) _Pragma("unroll") for (int k = 0; k < 2; ++k) \
        acc[ai][bj][m][n] = __builtin_amdgcn_mfma_f32_16x16x32_bf16(Bt[n][k], At[m][k], acc[ai][bj][m][n], 0, 0, 0); __builtin_amdgcn_s_setprio(0); } while (0)
#define PG8_WAIT_V(n) asm volatile("s_waitcnt vmcnt(" #n ")" ::: "memory")
#define PG8_WAIT_L(n) asm volatile("s_waitcnt lgkmcnt(" #n ")" ::: "memory")
#define PG8_BAR __builtin_amdgcn_s_barrier()
#define PG8_SCHED __builtin_amdgcn_sched_barrier(0)
    Unit cur, nxt; int ui = 0;
    if (!S.next(0, cur)) return;
    f32x4 acc[2][2][4][2];
#pragma unroll
    for (int a = 0; a < 2; ++a)
#pragma unroll
        for (int b = 0; b < 2; ++b)
#pragma unroll
            for (int m = 0; m < 4; ++m)
#pragma unroll
                for (int n = 0; n < 2; ++n) acc[a][b][m][n] = (f32x4){0.f, 0.f, 0.f, 0.f};
    bf16x8 At[4][2], B0[2][2], B1[2][2];
    const char* cA = (const char*)g.A + (size_t)cur.pm * tstep; const char* cB = (const char*)g.Bt + (size_t)cur.e * g.estride + (size_t)cur.pn * tstep;
    S.a_ready(cur);
    if constexpr (SP2) {
        PG8_STAGE(PG8_SB(0, 0), cB, voffB); PG8_STAGE(PG8_SB(0, 1), cB + hstep, voffB); PG8_STAGE(PG8_SA(0, 0), cA, voffA); PG8_STAGE(PG8_SA(0, 1), cA + hstep, voffA);
        if (wr == 1) PG8_BAR;
        PG8_WAIT_V(2); PG8_BAR;
        PG8_STAGE(PG8_SB(1, 0), cB + kstep, voffB); PG8_STAGE(PG8_SA(1, 0), cA + kstep, voffA); PG8_STAGE(PG8_SB(1, 1), cB + hstep + kstep, voffB);
        PG8_WAIT_V(6); PG8_BAR;
    } else {
        PG8_STAGE(PG8_SB(0, 0), cB, voffB); PG8_STAGE(PG8_SA(0, 0), cA, voffA); PG8_STAGE(PG8_SB(0, 1), cB + hstep, voffB); PG8_STAGE(PG8_SA(0, 1), cA + hstep, voffA);
        if (wr == 1) PG8_BAR;
        PG8_WAIT_V(4); PG8_BAR;
        PG8_STAGE(PG8_SB(1, 0), cB + kstep, voffB); PG8_STAGE(PG8_SA(1, 0), cA + kstep, voffA); PG8_STAGE(PG8_SB(1, 1), cB + hstep + kstep, voffB);
        PG8_WAIT_V(6); PG8_BAR;
    }
    for (;;) {
        const bool has_next = S.next(ui + 1, nxt);
        const char* nA = has_next ? (const char*)g.A + (size_t)nxt.pm * tstep : cA; const char* nB = has_next ? (const char*)g.Bt + (size_t)nxt.e * g.estride + (size_t)nxt.pn * tstep : cB;
        for (int t = 0; t < nt; t += 2) {
            const bool last = (t == nt - 2);
            const char* a1 = cA + (size_t)(t + 1) * kstep;
            const char* a2 = last ? nA : cA + (size_t)(t + 2) * kstep; const char* b2 = last ? nB : cB + (size_t)(t + 2) * kstep;
            const char* a3 = a2 + kstep; const char* b3 = b2 + kstep;
            if (last && has_next) S.a_ready(nxt);
            if constexpr (SP2) {
            PG8_LDB(B0, 0, 0); PG8_LDB(B1, 0, 1); PG8_SCHED; PG8_LDA(At, 0, 0); PG8_STAGE(PG8_SA(1, 1), a1 + hstep, voffA);
            PG8_WAIT_V(8); PG8_WAIT_L(0); PG8_BAR; PG8_MMA(0, 0, At, B0); PG8_MMA(0, 1, At, B1); PG8_BAR; PG8_SCHED;
            PG8_LDA(At, 0, 1); PG8_STAGE(PG8_SB(0, 0), b2, voffB); PG8_STAGE(PG8_SB(0, 1), b2 + hstep, voffB); PG8_STAGE(PG8_SA(0, 0), a2, voffA);
            PG8_WAIT_V(8); PG8_WAIT_L(0); PG8_BAR; PG8_MMA(1, 0, At, B0); PG8_MMA(1, 1, At, B1); PG8_BAR; PG8_SCHED;
            PG8_LDB(B0, 1, 0); PG8_LDB(B1, 1, 1); PG8_SCHED; PG8_LDA(At, 1, 0); PG8_STAGE(PG8_SA(0, 1), a2 + hstep, voffA);
            PG8_WAIT_V(8); PG8_WAIT_L(0); PG8_BAR; PG8_MMA(0, 0, At, B0); PG8_MMA(0, 1, At, B1); PG8_BAR; PG8_SCHED;
            PG8_LDA(At, 1, 1); PG8_STAGE(PG8_SB(1, 0), b3, voffB); PG8_STAGE(PG8_SB(1, 1), b3 + hstep, voffB); PG8_STAGE(PG8_SA(1, 0), a3, voffA);
            PG8_WAIT_V(8); PG8_WAIT_L(0); PG8_BAR; PG8_MMA(1, 0, At, B0); PG8_MMA(1, 1, At, B1); PG8_BAR; PG8_SCHED;
            } else {
            PG8_LDB(B0, 0, 0); PG8_SCHED; PG8_LDA(At, 0, 0); PG8_STAGE(PG8_SA(1, 1), a1 + hstep, voffA);
            PG8_WAIT_L(8); PG8_BAR; PG8_WAIT_L(0); PG8_MMA(0, 0, At, B0); PG8_BAR; PG8_SCHED;
            PG8_LDB(B1, 0, 1); PG8_STAGE(PG8_SB(0, 0), b2, voffB);
            PG8_BAR; PG8_WAIT_L(0); PG8_MMA(0, 1, At, B1); PG8_BAR;
            PG8_LDA(At, 0, 1); PG8_STAGE(PG8_SA(0, 0), a2, voffA);
            PG8_BAR; PG8_WAIT_L(0); PG8_MMA(1, 0, At, B0); PG8_BAR; PG8_SCHED;
            PG8_STAGE(PG8_SB(0, 1), b2 + hstep, voffB);
            PG8_WAIT_V(6); PG8_BAR; PG8_MMA(1, 1, At, B1); PG8_BAR;
            PG8_LDB(B0, 1, 0); PG8_SCHED; PG8_LDA(At, 1, 0); PG8_STAGE(PG8_SA(0, 1), a2 + hstep, voffA);
            PG8_WAIT_L(8); PG8_BAR; PG8_WAIT_L(0); PG8_MMA(0, 0, At, B0); PG8_BAR; PG8_SCHED;
            PG8_LDB(B1, 1, 1); PG8_STAGE(PG8_SB(1, 0), b3, voffB);
            PG8_BAR; PG8_WAIT_L(0); PG8_MMA(0, 1, At, B1); PG8_BAR;
            PG8_LDA(At, 1, 1); PG8_STAGE(PG8_SA(1, 0), a3, voffA);
            PG8_BAR; PG8_WAIT_L(0); PG8_MMA(1, 0, At, B0); PG8_BAR; PG8_SCHED;
            PG8_STAGE(PG8_SB(1, 1), b3 + hstep, voffB);
            PG8_WAIT_V(6); PG8_BAR; PG8_MMA(1, 1, At, B1); PG8_BAR;
            }
        }
        if constexpr (ALIGN_EPI) { if (wr == 0) PG8_BAR; }
        if constexpr (!Epi::AFTER_DRAIN) { E(acc, cur, wr, wc, fr, fq); S.done(cur); }
        if (!has_next) break;
#pragma unroll
        for (int a = 0; a < 2; ++a)
#pragma unroll
            for (int b = 0; b < 2; ++b)
#pragma unroll
                for (int m = 0; m < 4; ++m)
#pragma unroll
                    for (int n = 0; n < 2; ++n) acc[a][b][m][n] = (f32x4){0.f, 0.f, 0.f, 0.f};
        cur = nxt; cA = nA; cB = nB; ++ui;
        if constexpr (ALIGN_EPI) { if (wr == 1) PG8_BAR; }
    }
    PG8_WAIT_V(0);
    if constexpr (!ALIGN_EPI) { if (wr == 0) PG8_BAR; }
    PG8_BAR;
    if constexpr (Epi::AFTER_DRAIN) { E.fused(acc, cur, wr, wc, fr, fq, lds, wid, lane); S.done(cur); }
#undef PG8_SA
#undef PG8_SB
#undef PG8_STAGE
#undef PG8_LDA
#undef PG8_LDB
#undef PG8_MMA
#undef PG8_WAIT_V
#undef PG8_WAIT_L
#undef PG8_BAR
#undef PG8_SCHED
}
}

#ifndef PH_MASK
#define PH_MASK 0xffff
#endif
constexpr int NWAVES = 8;
#ifndef MK_N_LAUNCHES
#define MK_N_LAUNCHES 1
#endif
constexpr int PER_PHASE = 13;
constexpr int N_LAUNCHES = MK_N_LAUNCHES;

constexpr size_t MiB = 1u << 20;
constexpr size_t WS_CTL = 0, CTL_ZERO_BYTES = 1 * MiB;
constexpr size_t WS_MOD = 1 * MiB;
constexpr size_t WS_KSUM = 262144;
constexpr size_t WS_ROUTE = 2 * MiB;
constexpr size_t WS_LIST = 3 * MiB;
constexpr size_t WS_WIN = 5 * MiB, WS_WBA = 13 * MiB, WS_WCOMB = 14 * MiB, WS_WOUT = 15 * MiB, WS_WGU = 18 * MiB, WS_WD = 82 * MiB;
constexpr size_t WS_H = 114 * MiB;
constexpr size_t WS_AO = WS_H, WS_DP = WS_H + 16 * MiB;
constexpr size_t WS_PROJ = 146 * MiB;
constexpr size_t WS_T = 146 * MiB;
constexpr size_t WS_XG = 146 * MiB;
constexpr size_t WS_ACT = 226 * MiB;
constexpr size_t WS_Y = 146 * MiB;
constexpr size_t WS_END = 274 * MiB;
constexpr int CW_TMO = 0, CW_CODE = 1, CW_BAR = 4096, CW_ECNT = 16384;

constexpr int RING_OFF = 0, RING_BYTES = 131072;
constexpr int LDSCTL_OFF = RING_BYTES, MISC_OFF = LDSCTL_OFF + 320;
constexpr int TAB_OFF = LDSCTL_OFF + 512;
constexpr int BTAB_OFF = TAB_OFF, TOFF_OFF = TAB_OFF + 4096, ECNT_OFF = TOFF_OFF + 160, TILEE_OFF = ECNT_OFF + 128;
constexpr int LDS_BYTES = 147456;
static_assert(TILEE_OFF + 4 * MAXTILES <= LDS_BYTES, "LDS map");

using pg8::bf_lo; using pg8::bf_hi;
#define GAS __attribute__((address_space(1)))
#define LAS __attribute__((address_space(3)))
typedef unsigned short bf16;
typedef unsigned v4u __attribute__((ext_vector_type(4)));
typedef unsigned v2u __attribute__((ext_vector_type(2)));
typedef float f32x4 __attribute__((ext_vector_type(4)));
typedef GAS unsigned gu32;
#define RLX_AGENT __ATOMIC_RELAXED, __HIP_MEMORY_SCOPE_AGENT
#define LDS_WAIT() asm volatile("s_waitcnt lgkmcnt(0)" ::: "memory")
#define VM_WAIT() asm volatile("s_waitcnt vmcnt(0)" ::: "memory")
__device__ __forceinline__ unsigned f2bf(float f) { unsigned u = __builtin_bit_cast(unsigned, f); return (u + 0x7fffu + ((u >> 16) & 1u)) >> 16; }
__device__ __forceinline__ unsigned pk2(float lo, float hi) { return f2bf(lo) | (f2bf(hi) << 16); }
__device__ __forceinline__ float bf2f(bf16 v) { return __uint_as_float(((unsigned)v) << 16); }

#define XB_TMO      128
#define XB_XCNT(j)  (256  + 64 * (j))
#define XB_XSUB(j)  (1280 + 64 * (j))
#define XB_XGEN(j)  (2304 + 64 * (j))
#define XB_TOP      3328
#define XB_TOPGEN   3392
#define XCD_BAR_WORDS 3456
#define XB_SPIN_CAP (1u << 18)
__device__ __forceinline__ unsigned xb_ld(unsigned* p)              { return __hip_atomic_load(p, __ATOMIC_RELAXED, __HIP_MEMORY_SCOPE_AGENT); }
__device__ __forceinline__ unsigned xb_add(unsigned* p, unsigned v) { return __hip_atomic_fetch_add(p, v, __ATOMIC_RELAXED, __HIP_MEMORY_SCOPE_AGENT); }
__device__ __forceinline__ unsigned xb_xcc_id() { return (unsigned)__builtin_amdgcn_s_getreg((3 << 11) | 20) & 0xFu; }
#define XB_SPIN(cond, bar) do { unsigned _sp = 0; while (cond) { __builtin_amdgcn_s_sleep(1); \
    if ((++_sp & 255u) == 0u) { if (xb_ld(&(bar)[XB_TMO])) break; if (_sp > XB_SPIN_CAP) { atomicAdd(&(bar)[XB_TMO], 1u); break; } } } } while (0)

struct XcdBarrier {
    unsigned* bar; unsigned x;
    volatile LAS unsigned* st;
};

__device__ __forceinline__ XcdBarrier xcd_barrier_post(unsigned* bar, volatile LAS unsigned* st) {
    XcdBarrier b; b.bar = bar; b.x = xb_xcc_id(); b.st = st;
    if (threadIdx.x == 0) (void)xb_add(&bar[XB_XCNT(b.x)], 1u);
    return b;
}
__device__ __forceinline__ void xcd_barrier_complete(unsigned* bar, unsigned x, unsigned& nloc, unsigned& nx) {
    const unsigned G = gridDim.x * gridDim.y * gridDim.z;
    unsigned sum, cnt, mine, sp = 0u;
    for (;;) {
        sum = 0u; cnt = 0u; mine = 0u;
#pragma unroll
        for (unsigned j = 0; j < 16; ++j) { const unsigned c = xb_ld(&bar[XB_XCNT(j)]); sum += c; cnt += (c > 0u) ? 1u : 0u; mine = (j == x) ? c : mine; }
        if (sum == G) break;
        __builtin_amdgcn_s_sleep(1);
        if ((++sp & 255u) == 0u) { if (xb_ld(&bar[XB_TMO])) break; if (sp > XB_SPIN_CAP) { atomicAdd(&bar[XB_TMO], 1u); break; } }
    }
    nloc = mine > 0u ? mine : 1u; nx = cnt > 0u ? cnt : 1u;
}

__device__ __forceinline__ void xcd_barrier(const XcdBarrier& b) {
    asm volatile("s_waitcnt vmcnt(0)" ::: "memory");
    __syncthreads();
    if (threadIdx.x == 0) {
        unsigned* bar = b.bar;
        __builtin_amdgcn_s_waitcnt(0);
        unsigned nloc = b.st[0], nx = b.st[1];
        if (nloc == 0u) { xcd_barrier_complete(bar, b.x, nloc, nx); b.st[0] = nloc; b.st[1] = nx; }
        const unsigned old = xb_add(&bar[XB_XSUB(b.x)], 1u);
        const unsigned gen = old / nloc;
        if (old + 1u == (gen + 1u) * nloc) {
            __builtin_amdgcn_fence(__ATOMIC_RELEASE, "agent");
            asm volatile("s_waitcnt vmcnt(0)" ::: "memory");
            const unsigned og = xb_add(&bar[XB_TOP], 1u);
            const unsigned tg = og / nx;
            if (og + 1u == (tg + 1u) * nx) xb_add(&bar[XB_TOPGEN], 1u);
            else XB_SPIN(xb_ld(&bar[XB_TOPGEN]) == tg, bar);
            __builtin_amdgcn_fence(__ATOMIC_ACQUIRE, "agent");
            xb_add(&bar[XB_XGEN(b.x)], 1u);
            asm volatile("s_waitcnt vmcnt(0)" ::: "memory");
        } else {
            XB_SPIN(xb_ld(&bar[XB_XGEN(b.x)]) == gen, bar);
            __builtin_amdgcn_fence(__ATOMIC_ACQUIRE, "agent");
            asm volatile("s_waitcnt vmcnt(0)" ::: "memory");
        }
    }
    __syncthreads();
}

struct Args { const float* in[22]; float* out; unsigned char* ws; int ph_lo, ph_hi; };
struct Frame {
    LAS unsigned char* lds;
    volatile LAS unsigned* MISC;
    gu32* ctl;
    unsigned char* ws;
    int tid, lane, wave;
    int vcu, G;
    float* out;
};

__device__ __forceinline__ float wave_sum(float v) {
#pragma unroll
    for (int o = 1; o < 64; o <<= 1) v += __shfl_xor(v, o);
    return v;
}
__device__ __forceinline__ float wave_max(float v) {
#pragma unroll
    for (int o = 1; o < 64; o <<= 1) v = fmaxf(v, __shfl_xor(v, o));
    return v;
}

template <int MODE>
__device__ __forceinline__ void p0_transpose_item(const float* W, int K, int N, bf16* WT, int row_off, LAS float* scr, int item, int lane) {
    const int nblk = N / 32, kb = item / nblk, nb = item % nblk, k0 = 64 * kb, n0 = 32 * nb;
#pragma unroll 8
    for (int i = 0; i < 32; ++i) { const int kk = 2 * i + (lane >> 5); scr[kk * 33 + (lane & 31)] = W[(size_t)(k0 + kk) * N + n0 + (lane & 31)]; }
    LDS_WAIT(); asm volatile("" ::: "memory");
    const int c = lane & 7;
#pragma unroll
    for (int j = 0; j < 4; ++j) { const int n = (lane >> 3) + 8 * j; const LAS float* s = scr + (8 * c) * 33 + n;
        v4u o; o.x = pk2(s[0 * 33], s[1 * 33]); o.y = pk2(s[2 * 33], s[3 * 33]); o.z = pk2(s[4 * 33], s[5 * 33]); o.w = pk2(s[6 * 33], s[7 * 33]);
        const int ng = n0 + n;
        const int drow = MODE == 0 ? row_off + ng : (MODE == 1 ? 32 * (ng >> 4) + (ng & 15) : 32 * (ng >> 4) + 16 + (ng & 15));
        *(GAS v4u*)(WT + (size_t)drow * K + k0 + 8 * c) = o; }
    LDS_WAIT(); asm volatile("" ::: "memory");
}

__device__ __forceinline__ void p0_prologue(Frame& F, const Args& A) {
    {
        LAS float* cact = (LAS float*)(F.lds + RING_OFF);
        LAS float* part = cact + 2048;
        for (int i = F.tid; i < 2 * D; i += NWAVES * 64) { const float cv = A.in[1][i]; cact[i] = cv / (1.0f + __expf(-cv)); }
        __syncthreads();
        for (int ch = blockIdx.x; ch < (NMOD * D) / 64; ch += F.G) {
            const int n0 = ch * 64; float a0 = 0.f, a1 = 0.f;
            const float* wp = A.in[2] + (size_t)(F.wave * 128) * (NMOD * D) + n0 + F.lane;
#pragma unroll 8
            for (int k = 0; k < 128; ++k) { const float w = wp[(size_t)k * (NMOD * D)]; a0 += cact[F.wave * 128 + k] * w; a1 += cact[D + F.wave * 128 + k] * w; }
            part[(F.wave * 2 + 0) * 64 + F.lane] = a0; part[(F.wave * 2 + 1) * 64 + F.lane] = a1;
            __syncthreads();
            if (F.tid < 128) { const int b = F.tid >> 6, l = F.tid & 63; float s = 0.f;
#pragma unroll
                for (int w = 0; w < 8; ++w) s += part[(w * 2 + b) * 64 + l];
                ((float*)(F.ws + WS_MOD))[b * (NMOD * D) + n0 + l] = s + A.in[3][n0 + l]; }
            __syncthreads();
        }
        __syncthreads();
    }
    LAS float* scr = (LAS float*)(F.lds + RING_OFF + F.wave * 16384);
    const int gw = F.vcu * NWAVES + F.wave, NGW = F.G * NWAVES;
    {
        bf16* WcT = (bf16*)(F.ws + WS_WCOMB); const float* pw = A.in[8]; const float* ps = A.in[9]; const float* wbp = A.in[11];
        for (int it = gw; it < (PW / 8) * (D / 64); it += NGW) {
            const int c0 = (it >> 4) * 8, n = (it & 15) * 64 + F.lane, g = c0 >> 7;
            float a[8];
#pragma unroll
            for (int i = 0; i < 8; ++i) a[i] = 0.f;
            for (int d = 0; d < PGW; ++d) { const float wv = wbp[(size_t)(g * PGW + d) * D + n] * ps[g * PGW + d];
#pragma unroll
                for (int i = 0; i < 8; ++i) a[i] += pw[(size_t)(g * PGW + (c0 & 127) + i) * PGW + d] * wv; }
            v4u o; o.x = pk2(a[0], a[1]); o.y = pk2(a[2], a[3]); o.z = pk2(a[4], a[5]); o.w = pk2(a[6], a[7]);
            *(v4u*)(WcT + (size_t)n * PW + c0) = o; }
    }
    constexpr int I_IN = (D / 64) * (INW / 32), I_BA = (AW / 64) * (D / 32), I_BP = (PW / 64) * (D / 32), I_OUT = (D / 64) * (D / 32);
    constexpr int I_EG = (D / 64) * (DE / 32), I_ED = (DE / 64) * (D / 32);
    constexpr int NITEMS = I_IN + I_BA + I_OUT + NE * (2 * I_EG + I_ED);
    bf16* WinT = (bf16*)(F.ws + WS_WIN); bf16* WbaT = (bf16*)(F.ws + WS_WBA); bf16* WoutT = (bf16*)(F.ws + WS_WOUT);
    bf16* WguT = (bf16*)(F.ws + WS_WGU); bf16* WdT = (bf16*)(F.ws + WS_WD);
    for (int it = gw; it < NITEMS; it += NGW) {
        int r = it;
        if (r < I_IN) { p0_transpose_item<0>(A.in[5], D, INW, WinT, 0, scr, r, F.lane); continue; } r -= I_IN;
        if (r < I_BA) { p0_transpose_item<0>(A.in[10], AW, D, WbaT, 0, scr, r, F.lane); continue; } r -= I_BA;
        if (r < I_OUT) { p0_transpose_item<0>(A.in[12], D, D, WoutT, 0, scr, r, F.lane); continue; } r -= I_OUT;
        if (r < NE * I_EG) { const int e = r / I_EG; p0_transpose_item<1>(A.in[18] + (size_t)e * D * DE, D, DE, WguT + (size_t)e * D * D, 0, scr, r % I_EG, F.lane); continue; } r -= NE * I_EG;
        if (r < NE * I_EG) { const int e = r / I_EG; p0_transpose_item<2>(A.in[19] + (size_t)e * D * DE, D, DE, WguT + (size_t)e * D * D, 0, scr, r % I_EG, F.lane); continue; } r -= NE * I_EG;
        { const int e = r / I_ED; p0_transpose_item<0>(A.in[20] + (size_t)e * DE * D, DE, D, WdT + (size_t)e * D * DE, 0, scr, r % I_ED, F.lane); }
    }
}

__device__ __forceinline__ void p1_hrows(Frame& F, const Args& A) {
    const int gw = F.vcu * NWAVES + F.wave, NGW = F.G * NWAVES;
    const float* mod = (const float*)(F.ws + WS_MOD); bf16* H = (bf16*)(F.ws + WS_H);
    for (int m = gw; m < NTOK; m += NGW) {
        const float* md = mod + (m / SEQ) * (NMOD * D);
        const f32x4* xr = (const f32x4*)(A.in[0] + (size_t)m * D) + F.lane;
        f32x4 v[4]; float ss = 0.f;
#pragma unroll
        for (int j = 0; j < 4; ++j) { v[j] = xr[64 * j]; ss += (v[j].x * v[j].x + v[j].y * v[j].y) + (v[j].z * v[j].z + v[j].w * v[j].w); }
        const float rstd = 1.0f / sqrtf(wave_sum(ss) * (1.0f / D) + EPS);
#pragma unroll
        for (int j = 0; j < 4; ++j) { const int col = 4 * F.lane + 256 * j;
            const f32x4 g = *(const f32x4*)(A.in[4] + col), sh = *(const f32x4*)(md + col), sc = *(const f32x4*)(md + D + col);
            const f32x4 hh = (v[j] * rstd) * g * (sc + 1.0f) + sh;
            v2u o; o.x = pk2(hh.x, hh.y); o.y = pk2(hh.z, hh.w);
            *(v2u*)(H + (size_t)m * D + col) = o; }
    }
}

__device__ __forceinline__ void p3_pooldiff(Frame& F, const Args& A) {
    const int gw = F.vcu * NWAVES + F.wave, NGW = F.G * NWAVES, lane = F.lane;
    const bf16* Ut = (const bf16*)(F.ws + WS_PROJ) + (size_t)3 * NTOK * 512;
    bf16* DP = (bf16*)(F.ws + WS_DP);
    const int w = 2 << (lane >> 4);
    for (int m = gw; m < NTOK; m += NGW) {
        const int t = m & (SEQ - 1); const int cnt = (t + 1) < w ? (t + 1) : w;
        const bf16* up = Ut + (size_t)m * 512 + 8 * lane;
        const v4u u0 = *(const v4u*)up;
        float s[8] = {bf_lo(u0.x), bf_hi(u0.x), bf_lo(u0.y), bf_hi(u0.y), bf_lo(u0.z), bf_hi(u0.z), bf_lo(u0.w), bf_hi(u0.w)};
        float u[8];
#pragma unroll
        for (int i = 0; i < 8; ++i) u[i] = s[i];
        for (int k = 1; k < cnt; ++k) { const v4u v = *(const v4u*)(up - (size_t)k * 512);
            s[0] += bf_lo(v.x); s[1] += bf_hi(v.x); s[2] += bf_lo(v.y); s[3] += bf_hi(v.y); s[4] += bf_lo(v.z); s[5] += bf_hi(v.z); s[6] += bf_lo(v.w); s[7] += bf_hi(v.w); }
        const float inv = 1.0f / (float)cnt;
        v4u o; o.x = pk2(s[0] * inv - u[0], s[1] * inv - u[1]); o.y = pk2(s[2] * inv - u[2], s[3] * inv - u[3]); o.z = pk2(s[4] * inv - u[4], s[5] * inv - u[5]); o.w = pk2(s[6] * inv - u[6], s[7] * inv - u[7]);
        *(v4u*)(DP + (size_t)m * 512 + 8 * lane) = o;
    }
}

__device__ __forceinline__ void build_btab(Frame& F, const Args& A) {
    LAS float* btab = (LAS float*)(F.lds + BTAB_OFF);
    for (int i = F.tid; i < NH * 128; i += NWAVES * 64) { const int h = i >> 7, rel = i & 127; int bk;
        if (rel < 16) bk = rel;
        else { bk = 16; const int th[15] = {19, 21, 24, 27, 31, 35, 40, 46, 52, 59, 67, 77, 87, 99, 113};
#pragma unroll
            for (int q = 0; q < 15; ++q) bk += (rel >= th[q]) ? 1 : 0; }
        btab[i] = A.in[7][bk * NH + h]; }
    __syncthreads();
}

__device__ __forceinline__ void p4_attn_naive(Frame& F, const Args& A) {
    build_btab(F, A);
    const int gw = F.vcu * NWAVES + F.wave, NGW = F.G * NWAVES;
    const bf16* Qt = (const bf16*)(F.ws + WS_PROJ);
    const bf16* Kt = Qt + (size_t)1 * NTOK * 512;
    const bf16* Vt = Qt + (size_t)2 * NTOK * 512;
    const float* kmean = (const float*)(F.ws + WS_KSUM);
    bf16* AO = (bf16*)(F.ws + WS_AO);
    const LAS float* btab = (const LAS float*)(F.lds + BTAB_OFF);
    LAS float* qs = (LAS float*)(F.lds + RING_OFF + F.wave * 8192);
    LAS float* ps = qs + 64;
    const int lane = F.lane;
    for (int it = gw; it < NTOK * NH; it += NGW) {
        const int h = it & 7, m = it >> 3, b = m / SEQ, t = m & (SEQ - 1), blk = t >> 8;
        qs[lane] = bf2f(Qt[(size_t)m * 512 + h * HD + lane]);
        LDS_WAIT(); asm volatile("" ::: "memory");
        float q[64];
#pragma unroll
        for (int d4 = 0; d4 < 16; ++d4) { const f32x4 v = *(const LAS f32x4*)(qs + 4 * d4); q[4 * d4] = v.x; q[4 * d4 + 1] = v.y; q[4 * d4 + 2] = v.z; q[4 * d4 + 3] = v.w; }
        float sc = -3.0e38f;
        if (lane < blk) { const f32x4* km = (const f32x4*)(kmean + (size_t)((b * NH + h) * NBLK + lane) * HD); float s = 0.f;
#pragma unroll
            for (int d4 = 0; d4 < 16; ++d4) { const f32x4 kv = km[d4]; s += q[4 * d4] * kv.x + q[4 * d4 + 1] * kv.y + q[4 * d4 + 2] * kv.z + q[4 * d4 + 3] * kv.w; }
            sc = s; }
        int sel[3];
#pragma unroll
        for (int i = 0; i < 3; ++i) { const float mx = wave_max(sc); const unsigned long long mk = __ballot(sc == mx && lane < blk);
            const int idx = mk ? (int)__builtin_ctzll(mk) : 0; sel[i] = idx; if (lane == idx) sc = -3.0e38f; }
        const int nsel = blk < 3 ? blk : 3;
        float lg[4][4];
#pragma unroll
        for (int s = 0; s < 4; ++s) {
            const bool valid = (s == 3) || (s < nsel);
            const int jb = (s == 3) ? blk : sel[s < 3 ? s : 0];
#pragma unroll
            for (int i = 0; i < 4; ++i) {
                float lgt = NEG_INF;
                if (valid) { const int kk = lane + 64 * i, kpos = jb * MBLK + kk;
                    const v4u* kr = (const v4u*)(Kt + (size_t)(b * SEQ + kpos) * 512 + h * HD); float dsum = 0.f;
#pragma unroll
                    for (int c8 = 0; c8 < 8; ++c8) { const v4u kv = kr[c8];
                        dsum += q[8 * c8 + 0] * __uint_as_float(kv.x << 16) + q[8 * c8 + 1] * __uint_as_float(kv.x & 0xffff0000u)
                              + q[8 * c8 + 2] * __uint_as_float(kv.y << 16) + q[8 * c8 + 3] * __uint_as_float(kv.y & 0xffff0000u)
                              + q[8 * c8 + 4] * __uint_as_float(kv.z << 16) + q[8 * c8 + 5] * __uint_as_float(kv.z & 0xffff0000u)
                              + q[8 * c8 + 6] * __uint_as_float(kv.w << 16) + q[8 * c8 + 7] * __uint_as_float(kv.w & 0xffff0000u); }
                    const int rel = t - kpos;
                    if (rel >= 0) lgt = dsum * 0.125f + btab[h * 128 + (rel > 127 ? 127 : rel)]; }
                lg[s][i] = lgt; }
        }
        float mx = NEG_INF;
#pragma unroll
        for (int s = 0; s < 4; ++s)
#pragma unroll
            for (int i = 0; i < 4; ++i) mx = fmaxf(mx, lg[s][i]);
        mx = wave_max(mx);
        float sum = 0.f;
#pragma unroll
        for (int s = 0; s < 4; ++s)
#pragma unroll
            for (int i = 0; i < 4; ++i) { const float e = (lg[s][i] <= -1e29f) ? 0.f : __expf(lg[s][i] - mx); lg[s][i] = e; sum += e; }
        sum = wave_sum(sum);
        const float inv = 1.0f / sum;
#pragma unroll
        for (int s = 0; s < 4; ++s)
#pragma unroll
            for (int i = 0; i < 4; ++i) ps[s * 256 + lane + 64 * i] = lg[s][i] * inv;
        LDS_WAIT(); asm volatile("" ::: "memory");
        float o = 0.f;
#pragma unroll
        for (int s = 0; s < 4; ++s) {
            const bool valid = (s == 3) || (s < nsel);
            if (valid) { const int jb = (s == 3) ? blk : sel[s < 3 ? s : 0];
                const int nk = (s == 3) ? (((t & 255) + 4) & ~3) : 256;
                const bf16* vp = Vt + (size_t)(b * SEQ + jb * MBLK) * 512 + h * HD + lane;
                for (int kk = 0; kk < nk; kk += 4) { const f32x4 p4 = *(const LAS f32x4*)(ps + s * 256 + kk);
                    o += p4.x * bf2f(vp[(size_t)(kk + 0) * 512]) + p4.y * bf2f(vp[(size_t)(kk + 1) * 512]) + p4.z * bf2f(vp[(size_t)(kk + 2) * 512]) + p4.w * bf2f(vp[(size_t)(kk + 3) * 512]); } }
        }
        AO[(size_t)m * 512 + h * HD + lane] = (bf16)f2bf(o);
        LDS_WAIT(); asm volatile("" ::: "memory");
    }
}

__device__ __forceinline__ void p7_norm_route(Frame& F, const Args& A) {
    const int gw = F.vcu * NWAVES + F.wave, NGW = F.G * NWAVES, lane = F.lane;
    const float* mod = (const float*)(F.ws + WS_MOD); bf16* H2 = (bf16*)(F.ws + WS_H);
    int* route = (int*)(F.ws + WS_ROUTE); int* list = (int*)(F.ws + WS_LIST);
    LAS float* hs = (LAS float*)(F.lds + RING_OFF + F.wave * 16384);
    const float* w_rg = A.in[14]; const float* w_re = A.in[16];
    const float* wcol = lane < 32 ? w_re + lane : w_rg + ((lane - 32) & 3);
    const int wstride = lane < 32 ? NE : 4;
    const float bias = lane < 32 ? A.in[17][lane] : A.in[15][(lane - 32) & 3];
    for (int m0 = gw * 4; m0 < NTOK; m0 += NGW * 4) {
        const float* md = mod + (m0 / SEQ) * (NMOD * D);
#pragma unroll
        for (int r = 0; r < 4; ++r) { const int m = m0 + r;
            const f32x4* xr = (const f32x4*)(F.out + (size_t)m * D) + lane;
            f32x4 v[4]; float ss = 0.f;
#pragma unroll
            for (int j = 0; j < 4; ++j) { v[j] = xr[64 * j]; ss += (v[j].x * v[j].x + v[j].y * v[j].y) + (v[j].z * v[j].z + v[j].w * v[j].w); }
            const float rstd = 1.0f / sqrtf(wave_sum(ss) * (1.0f / D) + EPS);
#pragma unroll
            for (int j = 0; j < 4; ++j) { const int col = 4 * lane + 256 * j;
                const f32x4 g = *(const f32x4*)(A.in[13] + col), sh = *(const f32x4*)(md + 3 * D + col), sc = *(const f32x4*)(md + 4 * D + col);
                const f32x4 hh = (v[j] * rstd) * g * (sc + 1.0f) + sh;
                v2u o; o.x = pk2(hh.x, hh.y); o.y = pk2(hh.z, hh.w);
                *(v2u*)(H2 + (size_t)m * D + col) = o;
                *(LAS f32x4*)(hs + r * 1024 + col) = hh; }
        }
        LDS_WAIT(); asm volatile("" ::: "memory");
        float z0 = 0.f, z1 = 0.f, z2 = 0.f, z3 = 0.f;
#pragma unroll 2
        for (int c = 0; c < D; c += 4) {
            const float wa = wcol[(size_t)(c + 0) * wstride], wb = wcol[(size_t)(c + 1) * wstride], wc_ = wcol[(size_t)(c + 2) * wstride], wd = wcol[(size_t)(c + 3) * wstride];
            const f32x4 h0 = *(const LAS f32x4*)(hs + c), h1 = *(const LAS f32x4*)(hs + 1024 + c), h2v = *(const LAS f32x4*)(hs + 2048 + c), h3 = *(const LAS f32x4*)(hs + 3072 + c);
            z0 += h0.x * wa + h0.y * wb + h0.z * wc_ + h0.w * wd;
            z1 += h1.x * wa + h1.y * wb + h1.z * wc_ + h1.w * wd;
            z2 += h2v.x * wa + h2v.y * wb + h2v.z * wc_ + h2v.w * wd;
            z3 += h3.x * wa + h3.y * wb + h3.z * wc_ + h3.w * wd;
        }
#pragma unroll
        for (int r = 0; r < 4; ++r) { const int m = m0 + r;
            const float z = (r == 0 ? z0 : (r == 1 ? z1 : (r == 2 ? z2 : z3))) + bias;
            const bool isg = lane >= 32 && lane < 36;
            const float vg = isg ? z : -3.0e38f;
            const float gm = wave_max(vg);
            const int gi = (int)__builtin_ctzll(__ballot(isg && vg == gm)) - 32;
            const float gs = wave_sum(isg ? __expf(vg - gm) : 0.f);
            const float pg = 1.0f / gs;
            const bool ing = lane < 32 && (lane >> 3) == gi;
            const float ve = ing ? z : -3.0e38f;
            const float e0m = wave_max(ve);
            const int ex0 = (int)__builtin_ctzll(__ballot(ing && ve == e0m));
            const float ve2 = (lane == ex0) ? -3.0e38f : ve;
            const float e1m = wave_max(ve2);
            const int ex1 = (int)__builtin_ctzll(__ballot(ing && lane != ex0 && ve2 == e1m));
            const float e1 = __expf(e1m - e0m); const float w0 = pg / (1.0f + e1), w1 = pg * e1 / (1.0f + e1);
            if (lane == 0) {
                const int p0 = (int)__hip_atomic_fetch_add((unsigned*)(F.ctl + CW_ECNT + 64 * ex0), 1u, RLX_AGENT);
                const int p1 = (int)__hip_atomic_fetch_add((unsigned*)(F.ctl + CW_ECNT + 64 * ex1), 1u, RLX_AGENT);
                list[(size_t)ex0 * NTOK + p0] = m; list[(size_t)ex1 * NTOK + p1] = m;
                int* rt = route + (size_t)m * 8; rt[0] = ex0; rt[1] = ex1; rt[2] = p0; rt[3] = p1; rt[4] = __float_as_int(w0); rt[5] = __float_as_int(w1);
            }
        }
        LDS_WAIT(); asm volatile("" ::: "memory");
    }
}

__device__ __forceinline__ void build_tables(Frame& F) {
    LAS int* toff = (LAS int*)(F.lds + TOFF_OFF); LAS int* ecnt = (LAS int*)(F.lds + ECNT_OFF); LAS int* tile_e = (LAS int*)(F.lds + TILEE_OFF);
    __syncthreads();
    if (F.tid < NE) ecnt[F.tid] = (int)__hip_atomic_load((unsigned*)(F.ctl + CW_ECNT + 64 * F.tid), RLX_AGENT);
    __syncthreads();
    if (F.tid == 0) { int o = 0; for (int e = 0; e < NE; ++e) { toff[e] = o; const int nt = (ecnt[e] + 255) >> 8; for (int k = 0; k < nt; ++k) tile_e[o + k] = e; o += nt; } toff[NE] = o; }
    __syncthreads();
}

__device__ __forceinline__ void p8_gather(Frame& F, const Args& A) {
    build_tables(F);
    const int gw = F.vcu * NWAVES + F.wave, NGW = F.G * NWAVES;
    const LAS int* toff = (const LAS int*)(F.lds + TOFF_OFF); const LAS int* ecnt = (const LAS int*)(F.lds + ECNT_OFF); const LAS int* tile_e = (const LAS int*)(F.lds + TILEE_OFF);
    const bf16* H2 = (const bf16*)(F.ws + WS_H); bf16* XG = (bf16*)(F.ws + WS_XG); const int* list = (const int*)(F.ws + WS_LIST);
    const int nrows = toff[NE] * 256;
    for (int r = gw; r < nrows; r += NGW) {
        const int e = tile_e[r >> 8], p = r - toff[e] * 256;
        v4u a = (v4u){0u, 0u, 0u, 0u}, bq = a;
        if (p < ecnt[e]) { const int tok = list[(size_t)e * NTOK + p]; const v4u* src = (const v4u*)(H2 + (size_t)tok * D); a = src[F.lane]; bq = src[F.lane + 64]; }
        v4u* dst = (v4u*)(XG + (size_t)r * D); dst[F.lane] = a; dst[F.lane + 64] = bq;
    }
}

__device__ __forceinline__ void p11_final(Frame& F, const Args& A) {
    build_tables(F);
    const int gw = F.vcu * NWAVES + F.wave, NGW = F.G * NWAVES;
    const LAS int* toff = (const LAS int*)(F.lds + TOFF_OFF);
    const float* mod = (const float*)(F.ws + WS_MOD); const bf16* Y = (const bf16*)(F.ws + WS_Y); const int* route = (const int*)(F.ws + WS_ROUTE);
    for (int m = gw; m < NTOK; m += NGW) {
        const float* md = mod + (m / SEQ) * (NMOD * D);
        const int* rt = route + (size_t)m * 8;
        const int e0 = rt[0], e1 = rt[1], p0 = rt[2], p1 = rt[3]; const float w0 = __int_as_float(rt[4]), w1 = __int_as_float(rt[5]);
        const size_t r0 = (size_t)toff[e0] * 256 + p0, r1 = (size_t)toff[e1] * 256 + p1;
        f32x4* xr = (f32x4*)(F.out + (size_t)m * D) + F.lane;
        f32x4 v[4]; float ss = 0.f;
#pragma unroll
        for (int j = 0; j < 4; ++j) { const int col = 4 * F.lane + 256 * j;
            const v2u y0 = *(const v2u*)(Y + r0 * D + col), y1 = *(const v2u*)(Y + r1 * D + col);
            const f32x4 g2 = *(const f32x4*)(md + 5 * D + col);
            f32x4 yy; yy.x = w0 * __uint_as_float(y0.x << 16) + w1 * __uint_as_float(y1.x << 16); yy.y = w0 * __uint_as_float(y0.x & 0xffff0000u) + w1 * __uint_as_float(y1.x & 0xffff0000u);
            yy.z = w0 * __uint_as_float(y0.y << 16) + w1 * __uint_as_float(y1.y << 16); yy.w = w0 * __uint_as_float(y0.y & 0xffff0000u) + w1 * __uint_as_float(y1.y & 0xffff0000u);
            v[j] = xr[64 * j] + g2 * yy;
            ss += (v[j].x * v[j].x + v[j].y * v[j].y) + (v[j].z * v[j].z + v[j].w * v[j].w); }
        const float rstd = 1.0f / sqrtf(wave_sum(ss) * (1.0f / D) + EPS);
#pragma unroll
        for (int j = 0; j < 4; ++j) { const int col = 4 * F.lane + 256 * j; const f32x4 g = *(const f32x4*)(A.in[21] + col); xr[64 * j] = (v[j] * rstd) * g; }
    }
}


namespace att {
typedef float f32x16 __attribute__((ext_vector_type(16)));
typedef short bf16x8 __attribute__((ext_vector_type(8)));
typedef short s16x4 __attribute__((ext_vector_type(4)));
typedef short v4i16_t __attribute__((ext_vector_type(4)));
constexpr float LOG2E = 1.4426950408889634f, C2 = 0.125f * LOG2E;
constexpr int KIMG = 0, VIMG = 32768, LIST_OFF = 65536, CNT_OFF = 73728, WSF_OFF = 73728 + 256;
constexpr size_t PLANE = (size_t)NTOK * NH * HD;
__device__ __forceinline__ int crow(int r, int hi) { return (r & 3) + 8 * (r >> 2) + 4 * hi; }
__device__ __forceinline__ s16x4 vtr(const LAS unsigned char* p) { return __builtin_bit_cast(s16x4, __builtin_amdgcn_ds_read_tr16_b64_v4i16((LAS v4i16_t*)p)); }
__device__ __forceinline__ float swap_max(float v) { auto rr = __builtin_amdgcn_permlane32_swap(__float_as_uint(v), __float_as_uint(v), false, false); return fmaxf(__uint_as_float(rr[0]), __uint_as_float(rr[1])); }
__device__ __forceinline__ float swap_sum(float v) { auto rr = __builtin_amdgcn_permlane32_swap(__float_as_uint(v), __float_as_uint(v), false, false); return __uint_as_float(rr[0]) + __uint_as_float(rr[1]); }

__device__ __forceinline__ void load_kv(LAS unsigned char* lds, const bf16* Kt, const bf16* Vt, int b, int h, int jb, int tid, int wave) {
    const bf16* kb = Kt + (size_t)(b * SEQ + jb * MBLK) * 512 + h * HD;
    const bf16* vb = Vt + (size_t)(b * SEQ + jb * MBLK) * 512 + h * HD;
#pragma unroll
    for (int i = 0; i < 4; ++i) { const int g = tid + 512 * i, row = g >> 3, cp = g & 7;
        const int ck = cp ^ ((row >> 1) & 7);
        __builtin_amdgcn_global_load_lds((const unsigned*)(kb + (size_t)row * 512 + ck * 8), (LAS unsigned*)(lds + KIMG + wave * 1024 + i * 8192), 16, 0, 0);
        const int dv = (((cp >> 2) ^ ((row >> 1) & 1)) << 5) + ((cp & 3) << 3);
        __builtin_amdgcn_global_load_lds((const unsigned*)(vb + (size_t)row * 512 + dv), (LAS unsigned*)(lds + VIMG + wave * 1024 + i * 8192), 16, 0, 0); }
}

__device__ __forceinline__ void qk_tile(f32x16& S, const LAS unsigned char* lds, int kt, const int (&kb)[4], const bf16x8 (&qr)[4]) {
    f32x16 acc = {};
#pragma unroll
    for (int d0 = 0; d0 < 4; ++d0) { const bf16x8 kf = *(const LAS bf16x8*)(lds + KIMG + kt * 4096 + kb[d0]); acc = __builtin_amdgcn_mfma_f32_32x32x16_bf16(kf, qr[d0], acc, 0, 0, 0); }
    S = acc;
}
__device__ __forceinline__ bf16x8 pack_p(const f32x16& P, int s) {
    pg8::u32x4 w; w.x = pg8::cvt_pk_bf16(P[8 * s + 0], P[8 * s + 1]); w.y = pg8::cvt_pk_bf16(P[8 * s + 2], P[8 * s + 3]); w.z = pg8::cvt_pk_bf16(P[8 * s + 4], P[8 * s + 5]); w.w = pg8::cvt_pk_bf16(P[8 * s + 6], P[8 * s + 7]);
    return __builtin_bit_cast(bf16x8, w);
}
__device__ __forceinline__ void pv_tile(f32x16& o0, f32x16& o1, const f32x16& P, const LAS unsigned char* lds, int kt, int vb0, int vb1) {
#pragma unroll
    for (int s = 0; s < 2; ++s) { const bf16x8 pa = pack_p(P, s); const int off = VIMG + (32 * kt + 16 * s) * 128;
        const s16x4 l0 = vtr(lds + off + vb0), h0 = vtr(lds + off + 1024 + vb0), l1 = vtr(lds + off + vb1), h1 = vtr(lds + off + 1024 + vb1);
        const bf16x8 b0 = (bf16x8){l0[0], l0[1], l0[2], l0[3], h0[0], h0[1], h0[2], h0[3]}, b1 = (bf16x8){l1[0], l1[1], l1[2], l1[3], h1[0], h1[1], h1[2], h1[3]};
        o0 = __builtin_amdgcn_mfma_f32_32x32x16_bf16(pa, b0, o0, 0, 0, 0); o1 = __builtin_amdgcn_mfma_f32_32x32x16_bf16(pa, b1, o1, 0, 0, 0); }
}

struct SelUnit { unsigned char j, qlo, qhi, pad; };
constexpr int SU_MAX = 192;
struct SelTable { SelUnit u[SU_MAX]; int n; };
constexpr float su_expect(int qb) { return 256.f * (qb < 3 ? (float)qb : 3.f) / (float)qb; }
constexpr SelTable make_sel_table() {
    SelTable T{}; float ex[SU_MAX] = {}; int n = 0;
    for (int j = 0; j < NBLK - 1; ++j) { int qb = j + 1;
        while (qb < NBLK) { const int lo = qb; float acc = 0.f;
            while (qb < NBLK && (qb - lo) < 16) { const float e = su_expect(qb); if (acc > 0.f && acc + e > 640.f) break; acc += e; ++qb; if (acc >= 512.f) break; }
            T.u[n].j = (unsigned char)j; T.u[n].qlo = (unsigned char)lo; T.u[n].qhi = (unsigned char)qb; T.u[n].pad = 0; ex[n] = acc; ++n; } }
    for (int i = 1; i < n; ++i) { const SelUnit u = T.u[i]; const float e = ex[i]; int k = i - 1; while (k >= 0 && ex[k] < e) { T.u[k + 1] = T.u[k]; ex[k + 1] = ex[k]; --k; } T.u[k + 1] = u; ex[k + 1] = e; }
    T.n = n; return T;
}
__device__ const SelTable g_seltab = make_sel_table();
}

__device__ __forceinline__ void p3_route(Frame& F) {
    const bf16* Qt = (const bf16*)(F.ws + WS_PROJ);
    const float* ksum = (const float*)(F.ws + WS_KSUM);
    unsigned* SEL = (unsigned*)(F.ws + WS_LIST);
    LAS float* ks = (LAS float*)(F.lds + RING_OFF);
    for (int w = blockIdx.x; w < 256; w += F.G) {
        const int bh = w >> 4, b = bh >> 3, h = bh & 7, t = (w & 15) * 512 + F.tid, blk = t >> 8;
        __syncthreads();
        { const f32x4 v = *(const f32x4*)(ksum + (size_t)bh * NBLK * HD + 4 * F.tid); *(LAS f32x4*)(ks + 4 * F.tid) = v; }
        __syncthreads();
        float q[64];
        { const v4u* qp = (const v4u*)(Qt + (size_t)(b * SEQ + t) * 512 + h * HD);
#pragma unroll
          for (int c8 = 0; c8 < 8; ++c8) { const v4u v = qp[c8]; q[8 * c8] = bf_lo(v.x); q[8 * c8 + 1] = bf_hi(v.x); q[8 * c8 + 2] = bf_lo(v.y); q[8 * c8 + 3] = bf_hi(v.y); q[8 * c8 + 4] = bf_lo(v.z); q[8 * c8 + 5] = bf_hi(v.z); q[8 * c8 + 6] = bf_lo(v.w); q[8 * c8 + 7] = bf_hi(v.w); } }
        float v0 = -3.0e38f, v1 = -3.0e38f, v2 = -3.0e38f; unsigned i0 = 255u, i1 = 255u, i2 = 255u;
        for (int j = 0; j < blk; ++j) { float s = 0.f;
#pragma unroll
            for (int d4 = 0; d4 < 16; ++d4) { const f32x4 kv = *(const LAS f32x4*)(ks + j * HD + 4 * d4); s += q[4 * d4] * kv.x + q[4 * d4 + 1] * kv.y + q[4 * d4 + 2] * kv.z + q[4 * d4 + 3] * kv.w; }
            if (s > v0) { v2 = v1; i2 = i1; v1 = v0; i1 = i0; v0 = s; i0 = (unsigned)j; }
            else if (s > v1) { v2 = v1; i2 = i1; v1 = s; i1 = (unsigned)j; }
            else if (s > v2) { v2 = s; i2 = (unsigned)j; } }
        SEL[(size_t)bh * SEQ + t] = i0 | (i1 << 8) | (i2 << 16) | 0xFF000000u;
    }
}

__device__ __forceinline__ void build_btab8(Frame& F, const Args& A, int h) {
    LAS float* btab = (LAS float*)(F.lds + BTAB_OFF);
    if (F.tid < 128) { const int rel = F.tid; int bk;
        if (rel < 16) bk = rel;
        else { bk = 16; const int th[15] = {19, 21, 24, 27, 31, 35, 40, 46, 52, 59, 67, 77, 87, 99, 113};
#pragma unroll
            for (int q = 0; q < 15; ++q) bk += (rel >= th[q]) ? 1 : 0; }
        btab[rel] = 8.0f * A.in[7][bk * NH + h]; }
    __syncthreads();
}

__device__ __forceinline__ void p4_selected(Frame& F, const Args& A) {
    using namespace att;
    const bf16* Qt = (const bf16*)(F.ws + WS_PROJ); const bf16* Kt = Qt + (size_t)1 * NTOK * 512; const bf16* Vt = Qt + (size_t)2 * NTOK * 512;
    const unsigned* SEL = (const unsigned*)(F.ws + WS_LIST);
    bf16* PO = (bf16*)F.out; float* PL = (float*)((unsigned char*)F.out + 3 * PLANE * 2);
    LAS unsigned char* lds = F.lds + RING_OFF;
    LAS unsigned short* list = (LAS unsigned short*)(lds + LIST_OFF); LAS unsigned* cntw = (LAS unsigned*)(lds + CNT_OFF);
    LAS float* wsf = (LAS float*)(lds + WSF_OFF + F.wave * 1024);
    const LAS float* btab = (const LAS float*)(F.lds + BTAB_OFF);
    const int lane = F.lane, r32 = lane & 31, hi = lane >> 5;
    const int swz = (r32 >> 1) & 7; int kb[4];
#pragma unroll
    for (int d0 = 0; d0 < 4; ++d0) kb[d0] = r32 * 128 + (((2 * d0 + hi) ^ swz) << 4);
    const int q_ = (lane & 15) >> 2, p_ = lane & 3, g1 = (lane >> 4) & 1;
    const int vb0 = (4 * hi + q_) * 128 + ((0 ^ (q_ >> 1)) << 6) + (16 * g1 + 4 * p_) * 2, vb1 = (4 * hi + q_) * 128 + ((1 ^ (q_ >> 1)) << 6) + (16 * g1 + 4 * p_) * 2;
    const int nunits = g_seltab.n * 16;
    int hprev = -1;
    for (int uidx = blockIdx.x; uidx < nunits; uidx += F.G) {
        const int ui = uidx >> 4, bh = uidx & 15, b = bh >> 3, h = bh & 7;
        const int j = g_seltab.u[ui].j, qlo = g_seltab.u[ui].qlo, qhi = g_seltab.u[ui].qhi;
        __syncthreads();
        if (h != hprev) { build_btab8(F, A, h); hprev = h; }
        load_kv(lds, Kt, Vt, b, h, j, F.tid, F.wave);
        if (F.tid == 0) *cntw = 0u;
        __syncthreads();
        for (int t0 = qlo * MBLK; t0 < qhi * MBLK; t0 += 512) { const int t = t0 + F.tid; const bool inr = t < qhi * MBLK;
            const unsigned sw = inr ? SEL[(size_t)bh * SEQ + t] : 0xFFFFFFFFu;
            const int slot = ((sw & 255u) == (unsigned)j) ? 0 : ((((sw >> 8) & 255u) == (unsigned)j) ? 1 : ((((sw >> 16) & 255u) == (unsigned)j) ? 2 : -1));
            const unsigned long long mk = __ballot(slot >= 0);
            if (mk) { unsigned base = 0u; if (lane == 0) base = __hip_atomic_fetch_add(cntw, (unsigned)__builtin_popcountll(mk), __ATOMIC_RELAXED, __HIP_MEMORY_SCOPE_WORKGROUP);
                base = (unsigned)__builtin_amdgcn_readfirstlane((int)base);
                if (slot >= 0) list[base + (unsigned)__builtin_popcountll(mk & ((1ull << lane) - 1ull))] = (unsigned short)(t | (slot << 13)); } }
        asm volatile("s_waitcnt vmcnt(0) lgkmcnt(0)" ::: "memory");
        __syncthreads();
        const int cnt = (int)*cntw, ntiles = (cnt + 31) >> 5;
        if (F.tid < 32 && cnt > 0) { const int idx = cnt + F.tid; if (idx < ntiles * 32) list[idx] = list[cnt - 1]; }
        __syncthreads();
        const float b31 = btab[127] * (0.125f * LOG2E);
        for (int tile = F.wave; tile < ntiles; tile += NWAVES) {
            const int ent = list[tile * 32 + r32]; const int tq = ent & 8191, slot = ent >> 13;
            bf16x8 qr[4];
            { const bf16* qp = Qt + (size_t)(b * SEQ + tq) * 512 + h * HD + 8 * hi;
#pragma unroll
              for (int d0 = 0; d0 < 4; ++d0) qr[d0] = *(const bf16x8*)(qp + 16 * d0); }
            f32x16 S[8];
#pragma unroll
            for (int kt = 0; kt < 8; ++kt) qk_tile(S[kt], lds, kt, kb, qr);
            const bool near = __ballot(tq < MBLK * (j + 1) + 112) != 0ull;
            if (near) {
#pragma unroll
                for (int kt = 0; kt < 8; ++kt)
#pragma unroll
                    for (int r = 0; r < 16; ++r) { const int rel = tq - (MBLK * j + 32 * kt + crow(r, hi)); S[kt][r] += btab[rel > 127 ? 127 : rel]; } }
            float mx = S[0][0];
#pragma unroll
            for (int kt = 0; kt < 8; ++kt)
#pragma unroll
                for (int r = 0; r < 16; ++r) mx = fmaxf(mx, S[kt][r]);
            mx = swap_max(mx);
            const float nm = -mx * C2; float l = 0.f;
#pragma unroll
            for (int kt = 0; kt < 8; ++kt)
#pragma unroll
                for (int r = 0; r < 16; ++r) { const float p = __builtin_amdgcn_exp2f(__builtin_fmaf(S[kt][r], C2, nm)); S[kt][r] = p; l += p; }
            l = swap_sum(l);
            f32x16 o0 = {}, o1 = {};
#pragma unroll
            for (int kt = 0; kt < 8; ++kt) pv_tile(o0, o1, S[kt], lds, kt, vb0, vb1);
            if (hi == 0) wsf[r32] = 1.0f / l;
            asm volatile("s_waitcnt lgkmcnt(0)" ::: "memory");
#pragma unroll
            for (int r = 0; r < 16; ++r) { const int qi = crow(r, hi); const float rl = wsf[qi]; const int e = list[tile * 32 + qi];
                if (tile * 32 + qi < cnt) { bf16* dst = PO + (size_t)(e >> 13) * PLANE + ((size_t)bh * SEQ + (e & 8191)) * HD + r32;
                    dst[0] = (bf16)f2bf(o0[r] * rl); dst[32] = (bf16)f2bf(o1[r] * rl); } }
            if (hi == 0 && tile * 32 + r32 < cnt) PL[((size_t)bh * SEQ + tq) * 4 + slot] = mx * C2 + (near ? 0.f : b31) + __builtin_amdgcn_logf(l);
            asm volatile("s_waitcnt lgkmcnt(0)" ::: "memory");
        }
    }
    __syncthreads();
}

__device__ __forceinline__ void p5_own(Frame& F, const Args& A) {
    using namespace att;
    const bf16* Qt = (const bf16*)(F.ws + WS_PROJ); const bf16* Kt = Qt + (size_t)1 * NTOK * 512; const bf16* Vt = Qt + (size_t)2 * NTOK * 512;
    const bf16* PO = (const bf16*)F.out; const float* PL = (const float*)((const unsigned char*)F.out + 3 * PLANE * 2);
    bf16* AO = (bf16*)(F.ws + WS_AO);
    LAS unsigned char* lds = F.lds + RING_OFF;
    LAS float* wsf = (LAS float*)(lds + WSF_OFF + F.wave * 1024);
    const LAS float* btab = (const LAS float*)(F.lds + BTAB_OFF);
    const int lane = F.lane, r32 = lane & 31, hi = lane >> 5, w = F.wave;
    const int swz = (r32 >> 1) & 7; int kb[4];
#pragma unroll
    for (int d0 = 0; d0 < 4; ++d0) kb[d0] = r32 * 128 + (((2 * d0 + hi) ^ swz) << 4);
    const int q_ = (lane & 15) >> 2, p_ = lane & 3, g1 = (lane >> 4) & 1;
    const int vb0 = (4 * hi + q_) * 128 + ((0 ^ (q_ >> 1)) << 6) + (16 * g1 + 4 * p_) * 2, vb1 = (4 * hi + q_) * 128 + ((1 ^ (q_ >> 1)) << 6) + (16 * g1 + 4 * p_) * 2;
    int hprev = -1;
    for (int uidx = blockIdx.x; uidx < 16 * NBLK; uidx += F.G) {
        const int bh = uidx & 15, qb = uidx >> 4, b = bh >> 3, h = bh & 7;
        __syncthreads();
        if (h != hprev) { build_btab8(F, A, h); hprev = h; }
        load_kv(lds, Kt, Vt, b, h, qb, F.tid, F.wave);
        asm volatile("s_waitcnt vmcnt(0)" ::: "memory");
        __syncthreads();
        const int tq = qb * MBLK + 32 * w + r32;
        bf16x8 qr[4];
        { const bf16* qp = Qt + (size_t)(b * SEQ + tq) * 512 + h * HD + 8 * hi;
#pragma unroll
          for (int d0 = 0; d0 < 4; ++d0) qr[d0] = *(const bf16x8*)(qp + 16 * d0); }
        float mx = -INFINITY;
#pragma unroll 1
        for (int kt = 0; kt <= w; ++kt) { f32x16 S; qk_tile(S, lds, kt, kb, qr);
#pragma unroll
            for (int r = 0; r < 16; ++r) { const int rel = (32 * w + r32) - (32 * kt + crow(r, hi));
                const float v = rel < 0 ? -INFINITY : S[r] + btab[rel > 127 ? 127 : rel]; mx = fmaxf(mx, v); } }
        mx = swap_max(mx);
        const float nm = -mx * C2; float l = 0.f;
        f32x16 o0 = {}, o1 = {};
#pragma unroll 1
        for (int kt = 0; kt <= w; ++kt) { f32x16 S; qk_tile(S, lds, kt, kb, qr);
#pragma unroll
            for (int r = 0; r < 16; ++r) { const int rel = (32 * w + r32) - (32 * kt + crow(r, hi));
                const float v = rel < 0 ? -INFINITY : S[r] + btab[rel > 127 ? 127 : rel];
                const float p = __builtin_amdgcn_exp2f(__builtin_fmaf(v, C2, nm)); S[r] = p; l += p; }
            pv_tile(o0, o1, S, lds, kt, vb0, vb1); }
        l = swap_sum(l);
        const int nsel = qb < 3 ? qb : 3;
        const float mo = mx * C2; const size_t qrow = (size_t)bh * SEQ + tq;
        float ls0 = -INFINITY, ls1 = -INFINITY, ls2 = -INFINITY;
        if (nsel > 0) ls0 = PL[qrow * 4 + 0];
        if (nsel > 1) ls1 = PL[qrow * 4 + 1];
        if (nsel > 2) ls2 = PL[qrow * 4 + 2];
        const float M = fmaxf(fmaxf(mo, ls0), fmaxf(ls1, ls2));
        const float wo = __builtin_amdgcn_exp2f(mo - M), w0 = __builtin_amdgcn_exp2f(ls0 - M), w1 = __builtin_amdgcn_exp2f(ls1 - M), w2 = __builtin_amdgcn_exp2f(ls2 - M);
        const float inv = 1.0f / (l * wo + w0 + w1 + w2);
        if (hi == 0) *(LAS f32x4*)(wsf + 4 * r32) = (f32x4){wo * inv, w0 * inv, w1 * inv, w2 * inv};
        asm volatile("s_waitcnt lgkmcnt(0)" ::: "memory");
#pragma unroll
        for (int r = 0; r < 16; ++r) { const int qi = crow(r, hi); const f32x4 f = *(const LAS f32x4*)(wsf + 4 * qi);
            const size_t prow = ((size_t)bh * SEQ + qb * MBLK + 32 * w + qi) * HD + r32;
            float a0 = o0[r] * f.x, a1 = o1[r] * f.x;
            if (nsel > 0) { a0 += f.y * bf2f(PO[prow]); a1 += f.y * bf2f(PO[prow + 32]); }
            if (nsel > 1) { a0 += f.z * bf2f(PO[PLANE + prow]); a1 += f.z * bf2f(PO[PLANE + prow + 32]); }
            if (nsel > 2) { a0 += f.w * bf2f(PO[2 * PLANE + prow]); a1 += f.w * bf2f(PO[2 * PLANE + prow + 32]); }
            bf16* dst = AO + (size_t)(b * SEQ + qb * MBLK + 32 * w + qi) * 512 + h * HD + r32;
            dst[0] = (bf16)f2bf(a0); dst[32] = (bf16)f2bf(a1); }
        asm volatile("s_waitcnt lgkmcnt(0)" ::: "memory");
    }
    __syncthreads();
}
__global__ void __launch_bounds__(NWAVES * 64, 2) mk_fwd(Args args) {
    extern __shared__ __attribute__((aligned(16))) unsigned char lds[];
    Frame F;
    F.lds = (LAS unsigned char*)lds;
    F.MISC = (volatile LAS unsigned*)(F.lds + MISC_OFF);
    F.tid = threadIdx.x; F.lane = F.tid & 63; F.wave = __builtin_amdgcn_readfirstlane(F.tid >> 6);
    F.G = gridDim.x; { const int bx = blockIdx.x; F.vcu = (F.G % 8 == 0) ? (bx % 8) * (F.G / 8) + bx / 8 : bx; }
    F.ws = args.ws; F.ctl = (gu32*)(args.ws + WS_CTL); F.out = args.out;
    for (int u = F.tid; u < (LDS_BYTES - LDSCTL_OFF) / 4; u += NWAVES * 64) ((LAS unsigned*)(F.lds + LDSCTL_OFF))[u] = 0u;
    __syncthreads();
    XcdBarrier bar; bar.bar = (unsigned*)(F.ctl + CW_BAR); bar.x = 0; bar.st = nullptr;
    if (N_LAUNCHES != PER_PHASE) bar = xcd_barrier_post((unsigned*)(F.ctl + CW_BAR), F.MISC + 8);
#define GRID_BAR(seam) do { if (N_LAUNCHES == PER_PHASE) { if (F.tid == 0) __hip_atomic_store(F.ctl + CW_TMO, 0xBADBA0u | (unsigned)(seam), RLX_AGENT); } else { xcd_barrier(bar); } } while (0)
    const int lo = args.ph_lo, hi = args.ph_hi;
#define IN(k) (lo <= (k) && (k) < hi)
#define PHM(k) ((PH_MASK >> (k)) & 1)
#define BOTH(k) (IN(k) && IN((k) + 1))
    bf16* PROJ = (bf16*)(F.ws + WS_PROJ);

    if (PHM(0) && IN(0)) { p0_prologue(F, args); if (BOTH(0)) GRID_BAR(0); }
    if (PHM(1) && IN(1)) { p1_hrows(F, args); if (BOTH(1)) GRID_BAR(1); }
    if (PHM(2) && IN(2)) {
        pg8::Gemm g{(const bf16*)(F.ws + WS_H), (const bf16*)(F.ws + WS_WIN), NTOK, INW, D, 0};
        pg8::StaticOrder S; S.init(NTOK, INW, F.G, (int)blockIdx.x);
        pg8::EpiProj E{PROJ, args.in[6], (float*)(F.ws + WS_KSUM)};
        pg8::gemm_phase<pg8::EpiProj, pg8::StaticOrder, true, true>(F.lds + RING_OFF, g, S, E);
        if (BOTH(2)) GRID_BAR(2);
    }
    if (PHM(3) && IN(3)) { p3_pooldiff(F, args); p3_route(F); if (BOTH(3)) GRID_BAR(3); }
#if defined(ATTN_NAIVE)
    if (PHM(4) && IN(4)) { p4_attn_naive(F, args); if (BOTH(4)) GRID_BAR(4); }
#else
    if (PHM(4) && IN(4)) { p4_selected(F, args); if (BOTH(4)) GRID_BAR(4); }
    if (PHM(5) && IN(5)) { p5_own(F, args); if (BOTH(5)) GRID_BAR(5); }
#endif
    if (PHM(6) && IN(6)) {
        bf16* T = (bf16*)(F.ws + WS_T);
        { pg8::Gemm g{(const bf16*)(F.ws + WS_AO), (const bf16*)(F.ws + WS_WBA), NTOK, D, AW, 0};
          pg8::StaticOrder S; S.init(NTOK, D, F.G, (int)blockIdx.x);
          pg8::EpiGate<false> E{PROJ + (size_t)4 * NTOK * 512, T};
          pg8::gemm_phase<pg8::EpiGate<false>, pg8::StaticOrder, false, true>(F.lds + RING_OFF, g, S, E); }
        VM_WAIT(); __syncthreads();
        { pg8::Gemm g{(const bf16*)(F.ws + WS_DP), (const bf16*)(F.ws + WS_WCOMB), NTOK, D, PW, 0};
          pg8::StaticOrder S; S.init(NTOK, D, F.G, (int)blockIdx.x);
          pg8::EpiGate<true> E{PROJ + (size_t)6 * NTOK * 512, T};
          pg8::gemm_phase<pg8::EpiGate<true>, pg8::StaticOrder, false, true>(F.lds + RING_OFF, g, S, E); }
        if (BOTH(6)) GRID_BAR(6);
    }
    if (PHM(7) && IN(7)) {
        pg8::Gemm g{(const bf16*)(F.ws + WS_T), (const bf16*)(F.ws + WS_WOUT), NTOK, D, D, 0};
        pg8::StaticOrder S; S.init(NTOK, D, F.G, (int)blockIdx.x);
        pg8::EpiRes E{args.in[0], F.out, (const float*)(F.ws + WS_MOD)};
        pg8::gemm_phase<pg8::EpiRes, pg8::StaticOrder, false, true>(F.lds + RING_OFF, g, S, E);
        if (BOTH(7)) GRID_BAR(7);
    }
    if (PHM(8) && IN(8)) { p7_norm_route(F, args); if (BOTH(8)) GRID_BAR(8); }
    if (PHM(9) && IN(9)) { p8_gather(F, args); if (BOTH(9)) GRID_BAR(9); }
    if (PHM(10) && IN(10)) {
        build_tables(F);
        const int ntiles = ((const LAS int*)(F.lds + TOFF_OFF))[NE];
        pg8::Gemm g{(const bf16*)(F.ws + WS_XG), (const bf16*)(F.ws + WS_WGU), ntiles * 256, D, D, (size_t)D * D * 2};
        pg8::GroupedOrder S; S.so.init(ntiles * 256, D, F.G, (int)blockIdx.x); S.tile_e = (const LAS int*)(F.lds + TILEE_OFF);
        pg8::EpiSwiglu E{(bf16*)(F.ws + WS_ACT)};
        pg8::gemm_phase<pg8::EpiSwiglu, pg8::GroupedOrder, true, true>(F.lds + RING_OFF, g, S, E);
        if (BOTH(10)) GRID_BAR(10);
    }
    if (PHM(11) && IN(11)) {
        build_tables(F);
        const int ntiles = ((const LAS int*)(F.lds + TOFF_OFF))[NE];
        pg8::Gemm g{(const bf16*)(F.ws + WS_ACT), (const bf16*)(F.ws + WS_WD), ntiles * 256, D, DE, (size_t)D * DE * 2};
        pg8::GroupedOrder S; S.so.init(ntiles * 256, D, F.G, (int)blockIdx.x); S.tile_e = (const LAS int*)(F.lds + TILEE_OFF);
        pg8::EpiY E{(bf16*)(F.ws + WS_Y)};
        pg8::gemm_phase<pg8::EpiY, pg8::GroupedOrder, true, true>(F.lds + RING_OFF, g, S, E);
        if (BOTH(11)) GRID_BAR(11);
    }
    if (PHM(12) && IN(12)) { p11_final(F, args); }
#undef IN
#undef BOTH
}

extern "C" void kernel_launch(void* const* d_in, const int* in_sizes, int n_in, void* d_out, int out_size, void* d_ws, size_t ws_size, hipStream_t stream) {
    static int grid = 0;
    if (grid == 0) {
        if (n_in != 22 || in_sizes[0] != NTOK * D || out_size != NTOK * D || ws_size < WS_END) { fprintf(stderr, "kernel_launch: unexpected shapes (n_in %d, in0 %d, out %d, ws %zu); nothing launched\n", n_in, n_in > 0 ? in_sizes[0] : -1, out_size, ws_size); grid = -1; return; }
        int dev = 0, cus = 0, per_cu = 0;
        if (hipGetDevice(&dev) != hipSuccess || hipDeviceGetAttribute(&cus, hipDeviceAttributeMultiprocessorCount, dev) != hipSuccess) { fprintf(stderr, "kernel_launch: device query failed\n"); grid = -1; return; }
        if (hipFuncSetAttribute((const void*)mk_fwd, hipFuncAttributeMaxDynamicSharedMemorySize, LDS_BYTES) != hipSuccess) { fprintf(stderr, "kernel_launch: hipFuncSetAttribute failed\n"); grid = -1; return; }
        if (hipOccupancyMaxActiveBlocksPerMultiprocessor(&per_cu, (const void*)mk_fwd, NWAVES * 64, LDS_BYTES) != hipSuccess || per_cu < 1)
            fprintf(stderr, "kernel_launch: note: occupancy query reports %d workgroups per CU\n", per_cu);
        (void)hipGetLastError();
        grid = cus;
    }
    if (grid < 0) return;
    if (hipMemsetAsync((char*)d_ws + WS_CTL, 0, CTL_ZERO_BYTES, stream) != hipSuccess) { fprintf(stderr, "kernel_launch: memset failed\n"); return; }
    Args a{};
    for (int i = 0; i < 22; ++i) a.in[i] = (const float*)d_in[i];
    a.out = (float*)d_out; a.ws = (unsigned char*)d_ws;
    if (N_LAUNCHES == 1) { a.ph_lo = 0; a.ph_hi = PER_PHASE; hipLaunchKernelGGL(mk_fwd, dim3(grid), dim3(NWAVES * 64), LDS_BYTES, stream, a); }
    else for (int li = 0; li < PER_PHASE; ++li) { a.ph_lo = li; a.ph_hi = li + 1; hipLaunchKernelGGL(mk_fwd, dim3(grid), dim3(NWAVES * 64), LDS_BYTES, stream, a); }
}
```

```cpp
#include <hip/hip_runtime.h>
#include <cstdio>
#include <cstdint>

constexpr int BATCH = 2, SEQ = 8192, D = 1024, NTOK = BATCH * SEQ;
constexpr int NH = 8, HD = 64, AW = 512, MBLK = 256, NBLK = SEQ / MBLK;
constexpr int PW = 512, PGW = 128;
constexpr int INW = 4096;
constexpr int NE = 32, DE = 512;
constexpr int NMOD = 6;
constexpr int MAXTILES = 160;
constexpr float EPS = 1e-6f;
constexpr float NEG_INF = -1e30f;

namespace pg8 {
#define PG8_LAS __attribute__((address_space(3)))
typedef unsigned short bf16_t;
typedef short bf16x8 __attribute__((ext_vector_type(8)));
typedef float f32x4 __attribute__((ext_vector_type(4)));
typedef unsigned u32x4 __attribute__((ext_vector_type(4)));
typedef unsigned u32x2 __attribute__((ext_vector_type(2)));
constexpr int BM = 256, BK = 64, HALF = 128, HTB = HALF * BK * 2  , STAGE_BYTES = 8 * HTB, NXCD = 8, WGM = 8;

__host__ __device__ __forceinline__ int lds_byte(int r, int c) { const int st = (r >> 4) * 2 + (c >> 5), rr = r & 15, cc = c & 31, ob = rr * 64 + cc * 2; return st * 1024 + (ob ^ (((ob >> 9) & 1) << 5)); }
__host__ __device__ __forceinline__ void stage_rc(int b, int& R, int& C) { const int st = b / 1024, sb = b % 1024, swz = sb ^ (((sb >> 9) & 1) << 5); R = (st >> 1) * 16 + swz / 64; C = (st & 1) * 32 + (swz % 64) / 2; }
__host__ __device__ __forceinline__ int perm32(int rho) { const int n = rho >> 4, i = rho & 15; return 8 * (i >> 2) + 4 * n + (i & 3); }

struct Unit { int pm, pn, e; };
struct Gemm { const bf16_t* A; const bf16_t* Bt; int M, N, K; size_t estride; };

struct StaticOrder {
    int nM, nN, nwg, G, c;
    __host__ __device__ void init(int M, int N, int G_, int c_) { nM = M / BM; nN = N / BM; nwg = nM * nN; G = G_; c = c_; }
    __host__ __device__ bool next(int i, Unit& u) const {
        const long L = (long)i * G + c; if (L >= nwg) return false;
        int wgid = (int)L; { const int q = nwg / NXCD, r = nwg % NXCD, xcd = wgid % NXCD, off = wgid / NXCD; wgid = (xcd < r ? xcd * (q + 1) : r * (q + 1) + (xcd - r) * q) + off; }
        const int nig = WGM * nN, gid = wgid / nig, fm = gid * WGM, gsz = (nM - fm) < WGM ? (nM - fm) : WGM;
        u.pm = fm + ((wgid % nig) % gsz); u.pn = (wgid % nig) / gsz; u.e = 0; return true;
    }
    __device__ __forceinline__ void a_ready(const Unit&) const {}
    __device__ __forceinline__ void done(const Unit&) const {}
};
struct GroupedOrder {
    StaticOrder so; const PG8_LAS int* tile_e;
    __device__ __forceinline__ bool next(int i, Unit& u) const {
        if (!so.next(i, u)) return false;
        u.e = __builtin_amdgcn_readfirstlane(tile_e[u.pm]); return true;
    }
    __device__ __forceinline__ void a_ready(const Unit&) const {}
    __device__ __forceinline__ void done(const Unit&) const {}
};

__device__ __forceinline__ unsigned cvt_pk_bf16(float lo, float hi) { unsigned r; asm volatile("v_cvt_pk_bf16_f32 %0, %1, %2" : "=v"(r) : "v"(lo), "v"(hi)); return r; }
__device__ __forceinline__ float bf_lo(unsigned u) { return __uint_as_float(u << 16); }
__device__ __forceinline__ float bf_hi(unsigned u) { return __uint_as_float(u & 0xffff0000u); }
__device__ __forceinline__ float sigm(float x) { return 1.0f / (1.0f + __expf(-x)); }
__device__ __forceinline__ u32x4 pack8(const f32x4 v0, const f32x4 v1) { u32x4 w; w.x = cvt_pk_bf16(v0[0], v0[1]); w.y = cvt_pk_bf16(v0[2], v0[3]); w.z = cvt_pk_bf16(v1[0], v1[1]); w.w = cvt_pk_bf16(v1[2], v1[3]); return w; }

struct EpiProj {
    static constexpr bool PERM = true, AFTER_DRAIN = false;
    bf16_t* O; const float* bgate; float* ksum;
    __device__ __forceinline__ void operator()(const f32x4 (&acc)[2][2][4][2], const Unit& u, int wr, int wc, int fr, int fq) const {
        const int t = u.pn >> 1, colt = (u.pn & 1) * 256; const bool gate = t >= 4;
        if (t == 1) {
#pragma unroll
            for (int bj = 0; bj < 2; ++bj)
#pragma unroll
                for (int n = 0; n < 2; ++n) { f32x4 s = (f32x4){0.f, 0.f, 0.f, 0.f};
#pragma unroll
                    for (int ai = 0; ai < 2; ++ai)
#pragma unroll
                        for (int m = 0; m < 4; ++m) s += acc[ai][bj][m][n];
#pragma unroll
                    for (int j = 0; j < 4; ++j) { float v = s[j]; v += __shfl_xor(v, 1); v += __shfl_xor(v, 2); v += __shfl_xor(v, 4); v += __shfl_xor(v, 8); s[j] = v; }
                    if (fr == 0) { const int c = colt + bj * HALF + wc * 32 + 8 * fq + 4 * n;
                        float* kp = ksum + (size_t)(((u.pm >> 5) * NH + (c >> 6)) * NBLK + (u.pm & 31)) * HD + (c & 63);
#pragma unroll
                        for (int j = 0; j < 4; ++j) atomicAdd(kp + j, s[j]); } }
        }
        bf16_t* base = O + (size_t)t * ((size_t)NTOK * 512);
        const int row0 = u.pm * BM + wr * 64 + fr, col0 = colt + wc * 32 + 8 * fq, bcol0 = u.pn * BM - 2048 + wc * 32 + 8 * fq;
        f32x4 bv[2][2];
#pragma unroll
        for (int bj = 0; bj < 2; ++bj)
#pragma unroll
            for (int n = 0; n < 2; ++n) bv[bj][n] = gate ? *(const f32x4*)(bgate + bcol0 + bj * HALF + 4 * n) : (f32x4){0.f, 0.f, 0.f, 0.f};
#pragma unroll
        for (int ai = 0; ai < 2; ++ai)
#pragma unroll
            for (int m = 0; m < 4; ++m) { bf16_t* rowp = base + (size_t)(row0 + ai * HALF + m * 16) * 512 + col0;
#pragma unroll
                for (int bj = 0; bj < 2; ++bj) { f32x4 v0 = acc[ai][bj][m][0] + bv[bj][0], v1 = acc[ai][bj][m][1] + bv[bj][1];
                    if (gate) {
#pragma unroll
                        for (int j = 0; j < 4; ++j) { v0[j] = sigm(v0[j]); v1[j] = sigm(v1[j]); } }
                    *(u32x4*)(rowp + bj * HALF) = pack8(v0, v1); } }
    }
};
template <bool SECOND> struct EpiGate {
    static constexpr bool PERM = true, AFTER_DRAIN = false;
    const bf16_t* G; bf16_t* T;
    __device__ __forceinline__ void operator()(const f32x4 (&acc)[2][2][4][2], const Unit& u, int wr, int wc, int fr, int fq) const {
        const bf16_t* gbase = G + (size_t)(u.pn >> 1) * ((size_t)NTOK * 512);
        const int row0 = u.pm * BM + wr * 64 + fr, gcol0 = (u.pn & 1) * 256 + wc * 32 + 8 * fq, col0 = u.pn * BM + wc * 32 + 8 * fq;
#pragma unroll
        for (int ai = 0; ai < 2; ++ai)
#pragma unroll
            for (int m = 0; m < 4; ++m) { const int r = row0 + ai * HALF + m * 16;
#pragma unroll
                for (int bj = 0; bj < 2; ++bj) {
                    const u32x4 gv = *(const u32x4*)(gbase + (size_t)r * 512 + gcol0 + bj * HALF);
                    bf16_t* tp = T + (size_t)r * 1024 + col0 + bj * HALF;
                    f32x4 v0 = acc[ai][bj][m][0] * (f32x4){bf_lo(gv.x), bf_hi(gv.x), bf_lo(gv.y), bf_hi(gv.y)};
                    f32x4 v1 = acc[ai][bj][m][1] * (f32x4){bf_lo(gv.z), bf_hi(gv.z), bf_lo(gv.w), bf_hi(gv.w)};
                    if (SECOND) { const u32x4 tv = *(const u32x4*)tp;
                        v0 += (f32x4){bf_lo(tv.x), bf_hi(tv.x), bf_lo(tv.y), bf_hi(tv.y)}; v1 += (f32x4){bf_lo(tv.z), bf_hi(tv.z), bf_lo(tv.w), bf_hi(tv.w)}; }
                    *(u32x4*)tp = pack8(v0, v1); } }
    }
};
struct EpiRes {
    static constexpr bool PERM = false, AFTER_DRAIN = false;
    const float* x; float* out; const float* mod;
    __device__ __forceinline__ void operator()(const f32x4 (&acc)[2][2][4][2], const Unit& u, int wr, int wc, int fr, int fq) const {
        const int b = (u.pm * BM) / SEQ; const float* gp = mod + b * (NMOD * D) + 2 * D;
        const int row0 = u.pm * BM + wr * 64 + fr, col0 = u.pn * BM + wc * 32 + 4 * fq;
        f32x4 gv[2][2];
#pragma unroll
        for (int bj = 0; bj < 2; ++bj)
#pragma unroll
            for (int n = 0; n < 2; ++n) gv[bj][n] = *(const f32x4*)(gp + col0 + bj * HALF + n * 16);
#pragma unroll
        for (int ai = 0; ai < 2; ++ai)
#pragma unroll
            for (int m = 0; m < 4; ++m) { const size_t off = (size_t)(row0 + ai * HALF + m * 16) * D + col0;
#pragma unroll
                for (int bj = 0; bj < 2; ++bj)
#pragma unroll
                    for (int n = 0; n < 2; ++n) { const f32x4 xs = *(const f32x4*)(x + off + bj * HALF + n * 16); *(f32x4*)(out + off + bj * HALF + n * 16) = xs + gv[bj][n] * acc[ai][bj][m][n]; } }
    }
};
struct EpiSwiglu {
    static constexpr bool PERM = false, AFTER_DRAIN = false;
    bf16_t* act;
    __device__ __forceinline__ void operator()(const f32x4 (&acc)[2][2][4][2], const Unit& u, int wr, int wc, int fr, int fq) const {
        const int row0 = u.pm * BM + wr * 64 + fr, col0 = u.pn * 128 + wc * 16 + 4 * fq;
#pragma unroll
        for (int ai = 0; ai < 2; ++ai)
#pragma unroll
            for (int m = 0; m < 4; ++m) { bf16_t* rowp = act + (size_t)(row0 + ai * HALF + m * 16) * DE + col0;
#pragma unroll
                for (int bj = 0; bj < 2; ++bj) { const f32x4 g = acc[ai][bj][m][0], up = acc[ai][bj][m][1]; f32x4 a;
#pragma unroll
                    for (int j = 0; j < 4; ++j) a[j] = g[j] * sigm(g[j]) * up[j];
                    u32x2 w; w.x = cvt_pk_bf16(a[0], a[1]); w.y = cvt_pk_bf16(a[2], a[3]);
                    *(u32x2*)(rowp + bj * 64) = w; } }
    }
};
struct EpiY {
    static constexpr bool PERM = true, AFTER_DRAIN = false;
    bf16_t* Y;
    __device__ __forceinline__ void operator()(const f32x4 (&acc)[2][2][4][2], const Unit& u, int wr, int wc, int fr, int fq) const {
        const int row0 = u.pm * BM + wr * 64 + fr, col0 = u.pn * BM + wc * 32 + 8 * fq;
#pragma unroll
        for (int ai = 0; ai < 2; ++ai)
#pragma unroll
            for (int m = 0; m < 4; ++m) { bf16_t* rowp = Y + (size_t)(row0 + ai * HALF + m * 16) * D + col0;
#pragma unroll
                for (int bj = 0; bj < 2; ++bj) *(u32x4*)(rowp + bj * HALF) = pack8(acc[ai][bj][m][0], acc[ai][bj][m][1]); }
    }
};

template <class Epi, class Sched, bool ALIGN_EPI = false, bool SP2 = false>
__device__ __forceinline__ void gemm_phase(PG8_LAS unsigned char* lds, const Gemm g, const Sched& S, const Epi& E) {
    const int tid = threadIdx.x, wid = __builtin_amdgcn_readfirstlane(tid >> 6), lane = tid & 63, wr = wid >> 2, wc = wid & 3, fr = lane & 15, fq = lane >> 4;
    const int K = g.K, nt = K / BK;
    unsigned voffA[2], voffB[2];
#pragma unroll
    for (int i = 0; i < 2; ++i) { int R, C; stage_rc(tid * 16 + i * 8192, R, C); const int Rb = Epi::PERM ? ((R & ~31) + perm32(R & 31)) : R;
        voffA[i] = (unsigned)(R * K + C) * 2u; voffB[i] = (unsigned)(Rb * K + C) * 2u; }
    const size_t kstep = (size_t)(BK * 2);
    const size_t hstep = (size_t)HALF * K * 2;
    const size_t tstep = 2 * hstep;
    const unsigned ldsw = (unsigned)wid * 1024u;
    const int aoff = lds_byte(wr * 64 + fr, fq * 8), boff = lds_byte(wc * 32 + fr, fq * 8);
#define PG8_SA(b, h) (((b) * 2 + (h)) * HTB)
#define PG8_SB(b, h) ((4 + (b) * 2 + (h)) * HTB)
#define PG8_STAGE(bufoff, gbase, voff) do { _Pragma("unroll") for (int _i = 0; _i < 2; ++_i) \
        __builtin_amdgcn_global_load_lds((const unsigned*)((const char*)(gbase) + (voff)[_i]), (PG8_LAS unsigned*)(lds + (bufoff) + ldsw + _i * 8192), 16, 0, 0); } while (0)
#define PG8_LDA(dst, b, h) do { _Pragma("unroll") for (int m = 0; m < 4; ++m) _Pragma("unroll") for (int k = 0; k < 2; ++k) dst[m][k] = *(const PG8_LAS bf16x8*)(lds + PG8_SA(b, h) + aoff + m * 2048 + k * 1024); } while (0)
#define PG8_LDB(dst, b, h) do { _Pragma("unroll") for (int n = 0; n < 2; ++n) _Pragma("unroll") for (int k = 0; k < 2; ++k) dst[n][k] = *(const PG8_LAS bf16x8*)(lds + PG8_SB(b, h) + boff + n * 2048 + k * 1024); } while (0)
#define PG8_MMA(ai, bj, At, Bt) do { __builtin_amdgcn_s_setprio(1); _Pragma("unroll") for (int m = 0; m < 4; ++m) _Pragma("unroll") for (int n = 0; n < 2; ++n) _Pragma("unroll") for (int k = 0; k < 2; ++k) \
        acc[ai][bj][m][n] = __builtin_amdgcn_mfma_f32_16x16x32_bf16(Bt[n][k], At[m][k], acc[ai][bj][m][n], 0, 0, 0); __builtin_amdgcn_s_setprio(0); } while (0)
#define PG8_WAIT_V(n) asm volatile("s_waitcnt vmcnt(" #n ")" ::: "memory")
#define PG8_WAIT_L(n) asm volatile("s_waitcnt lgkmcnt(" #n ")" ::: "memory")
#define PG8_BAR __builtin_amdgcn_s_barrier()
#define PG8_SCHED __builtin_amdgcn_sched_barrier(0)
    Unit cur, nxt; int ui = 0;
    if (!S.next(0, cur)) return;
    f32x4 acc[2][2][4][2];
#pragma unroll
    for (int a = 0; a < 2; ++a)
#pragma unroll
        for (int b = 0; b < 2; ++b)
#pragma unroll
            for (int m = 0; m < 4; ++m)
#pragma unroll
                for (int n = 0; n < 2; ++n) acc[a][b][m][n] = (f32x4){0.f, 0.f, 0.f, 0.f};
    bf16x8 At[4][2], B0[2][2], B1[2][2];
    const char* cA = (const char*)g.A + (size_t)cur.pm * tstep; const char* cB = (const char*)g.Bt + (size_t)cur.e * g.estride + (size_t)cur.pn * tstep;
    S.a_ready(cur);
    if constexpr (SP2) {
        PG8_STAGE(PG8_SB(0, 0), cB, voffB); PG8_STAGE(PG8_SB(0, 1), cB + hstep, voffB); PG8_STAGE(PG8_SA(0, 0), cA, voffA); PG8_STAGE(PG8_SA(0, 1), cA + hstep, voffA);
        if (wr == 1) PG8_BAR;
        PG8_WAIT_V(2); PG8_BAR;
        PG8_STAGE(PG8_SB(1, 0), cB + kstep, voffB); PG8_STAGE(PG8_SA(1, 0), cA + kstep, voffA); PG8_STAGE(PG8_SB(1, 1), cB + hstep + kstep, voffB);
        PG8_WAIT_V(6); PG8_BAR;
    } else {
        PG8_STAGE(PG8_SB(0, 0), cB, voffB); PG8_STAGE(PG8_SA(0, 0), cA, voffA); PG8_STAGE(PG8_SB(0, 1), cB + hstep, voffB); PG8_STAGE(PG8_SA(0, 1), cA + hstep, voffA);
        if (wr == 1) PG8_BAR;
        PG8_WAIT_V(4); PG8_BAR;
        PG8_STAGE(PG8_SB(1, 0), cB + kstep, voffB); PG8_STAGE(PG8_SA(1, 0), cA + kstep, voffA); PG8_STAGE(PG8_SB(1, 1), cB + hstep + kstep, voffB);
        PG8_WAIT_V(6); PG8_BAR;
    }
    for (;;) {
        const bool has_next = S.next(ui + 1, nxt);
        const char* nA = has_next ? (const char*)g.A + (size_t)nxt.pm * tstep : cA; const char* nB = has_next ? (const char*)g.Bt + (size_t)nxt.e * g.estride + (size_t)nxt.pn * tstep : cB;
        for (int t = 0; t < nt; t += 2) {
            const bool last = (t == nt - 2);
            const char* a1 = cA + (size_t)(t + 1) * kstep;
            const char* a2 = last ? nA : cA + (size_t)(t + 2) * kstep; const char* b2 = last ? nB : cB + (size_t)(t + 2) * kstep;
            const char* a3 = a2 + kstep; const char* b3 = b2 + kstep;
            if (last && has_next) S.a_ready(nxt);
            if constexpr (SP2) {
            PG8_LDB(B0, 0, 0); PG8_LDB(B1, 0, 1); PG8_SCHED; PG8_LDA(At, 0, 0); PG8_STAGE(PG8_SA(1, 1), a1 + hstep, voffA);
            PG8_WAIT_V(8); PG8_WAIT_L(0); PG8_BAR; PG8_MMA(0, 0, At, B0); PG8_MMA(0, 1, At, B1); PG8_BAR; PG8_SCHED;
            PG8_LDA(At, 0, 1); PG8_STAGE(PG8_SB(0, 0), b2, voffB); PG8_STAGE(PG8_SB(0, 1), b2 + hstep, voffB); PG8_STAGE(PG8_SA(0, 0), a2, voffA);
            PG8_WAIT_V(8); PG8_WAIT_L(0); PG8_BAR; PG8_MMA(1, 0, At, B0); PG8_MMA(1, 1, At, B1); PG8_BAR; PG8_SCHED;
            PG8_LDB(B0, 1, 0); PG8_LDB(B1, 1, 1); PG8_SCHED; PG8_LDA(At, 1, 0); PG8_STAGE(PG8_SA(0, 1), a2 + hstep, voffA);
            PG8_WAIT_V(8); PG8_WAIT_L(0); PG8_BAR; PG8_MMA(0, 0, At, B0); PG8_MMA(0, 1, At, B1); PG8_BAR; PG8_SCHED;
            PG8_LDA(At, 1, 1); PG8_STAGE(PG8_SB(1, 0), b3, voffB); PG8_STAGE(PG8_SB(1, 1), b3 + hstep, voffB); PG8_STAGE(PG8_SA(1, 0), a3, voffA);
            PG8_WAIT_V(8); PG8_WAIT_L(0); PG8_BAR; PG8_MMA(1, 0, At, B0); PG8_MMA(1, 1, At, B1); PG8_BAR; PG8_SCHED;
            } else {
            PG8_LDB(B0, 0, 0); PG8_SCHED; PG8_LDA(At, 0, 0); PG8_STAGE(PG8_SA(1, 1), a1 + hstep, voffA);
            PG8_WAIT_L(8); PG8_BAR; PG8_WAIT_L(0); PG8_MMA(0, 0, At, B0); PG8_BAR; PG8_SCHED;
            PG8_LDB(B1, 0, 1); PG8_STAGE(PG8_SB(0, 0), b2, voffB);
            PG8_BAR; PG8_WAIT_L(0); PG8_MMA(0, 1, At, B1); PG8_BAR;
            PG8_LDA(At, 0, 1); PG8_STAGE(PG8_SA(0, 0), a2, voffA);
            PG8_BAR; PG8_WAIT_L(0); PG8_MMA(1, 0, At, B0); PG8_BAR; PG8_SCHED;
            PG8_STAGE(PG8_SB(0, 1), b2 + hstep, voffB);
            PG8_WAIT_V(6); PG8_BAR; PG8_MMA(1, 1, At, B1); PG8_BAR;
            PG8_LDB(B0, 1, 0); PG8_SCHED; PG8_LDA(At, 1, 0); PG8_STAGE(PG8_SA(0, 1), a2 + hstep, voffA);
            PG8_WAIT_L(8); PG8_BAR; PG8_WAIT_L(0); PG8_MMA(0, 0, At, B0); PG8_BAR; PG8_SCHED;
            PG8_LDB(B1, 1, 1); PG8_STAGE(PG8_SB(1, 0), b3, voffB);
            PG8_BAR; PG8_WAIT_L(0); PG8_MMA(0, 1, At, B1); PG8_BAR;
            PG8_LDA(At, 1, 1); PG8_STAGE(PG8_SA(1, 0), a3, voffA);
            PG8_BAR; PG8_WAIT_L(0); PG8_MMA(1, 0, At, B0); PG8_BAR; PG8_SCHED;
            PG8_STAGE(PG8_SB(1, 1), b3 + hstep, voffB);
            PG8_WAIT_V(6); PG8_BAR; PG8_MMA(1, 1, At, B1); PG8_BAR;
            }
        }
        if constexpr (ALIGN_EPI) { if (wr == 0) PG8_BAR; }
        if constexpr (!Epi::AFTER_DRAIN) { E(acc, cur, wr, wc, fr, fq); S.done(cur); }
        if (!has_next) break;
#pragma unroll
        for (int a = 0; a < 2; ++a)
#pragma unroll
            for (int b = 0; b < 2; ++b)
#pragma unroll
                for (int m = 0; m < 4; ++m)
#pragma unroll
                    for (int n = 0; n < 2; ++n) acc[a][b][m][n] = (f32x4){0.f, 0.f, 0.f, 0.f};
        cur = nxt; cA = nA; cB = nB; ++ui;
        if constexpr (ALIGN_EPI) { if (wr == 1) PG8_BAR; }
    }
    PG8_WAIT_V(0);
    if constexpr (!ALIGN_EPI) { if (wr == 0) PG8_BAR; }
    PG8_BAR;
    if constexpr (Epi::AFTER_DRAIN) { E.fused(acc, cur, wr, wc, fr, fq, lds, wid, lane); S.done(cur); }
#undef PG8_SA
#undef PG8_SB
#undef PG8_STAGE
#undef PG8_LDA
#undef PG8_LDB
#undef PG8_MMA
#undef PG8_WAIT_V
#undef PG8_WAIT_L
#undef PG8_BAR
#undef PG8_SCHED
}
}

#ifndef PH_MASK
#define PH_MASK 0xffff
#endif
#ifndef PROBE_PHASE
#define PROBE_PHASE -1
#endif
constexpr int NWAVES = 8;
#ifndef MK_N_LAUNCHES
#define MK_N_LAUNCHES 1
#endif
constexpr int PER_PHASE = 13;
constexpr int N_LAUNCHES = MK_N_LAUNCHES;

constexpr size_t MiB = 1u << 20;
constexpr size_t WS_CTL = 0, CTL_ZERO_BYTES = 1 * MiB;
constexpr size_t WS_MOD = 1 * MiB;
constexpr size_t WS_WR = 1 * MiB + 65536;
constexpr size_t WS_KSUM = 262144;
constexpr size_t WS_ROUTE = 2 * MiB;
constexpr size_t WS_LIST = 3 * MiB;
constexpr size_t WS_WIN = 5 * MiB, WS_WBA = 13 * MiB, WS_WCOMB = 14 * MiB, WS_WOUT = 15 * MiB, WS_WGU = 18 * MiB, WS_WD = 82 * MiB;
constexpr size_t WS_H = 114 * MiB;
constexpr size_t WS_AO = WS_H, WS_DP = WS_H + 16 * MiB;
constexpr size_t WS_PROJ = 146 * MiB;
constexpr size_t WS_T = 146 * MiB;
constexpr size_t WS_XG = 146 * MiB;
constexpr size_t WS_ACT = 226 * MiB;
constexpr size_t WS_Y = 146 * MiB;
constexpr size_t WS_END = 274 * MiB;
constexpr int CW_TMO = 0, CW_CODE = 1, CW_BAR = 4096, CW_ECNT = 16384;

constexpr int RING_OFF = 0, RING_BYTES = 131072;
constexpr int LDSCTL_OFF = RING_BYTES, MISC_OFF = LDSCTL_OFF + 320;
constexpr int TAB_OFF = LDSCTL_OFF + 512;
constexpr int BTAB_OFF = TAB_OFF, TOFF_OFF = TAB_OFF + 4096, ECNT_OFF = TOFF_OFF + 160, TILEE_OFF = ECNT_OFF + 128;
constexpr int LDS_BYTES = 147456;
static_assert(TILEE_OFF + 4 * MAXTILES <= LDS_BYTES, "LDS map");

using pg8::bf_lo; using pg8::bf_hi;
#define GAS __attribute__((address_space(1)))
#define LAS __attribute__((address_space(3)))
typedef unsigned short bf16;
typedef unsigned v4u __attribute__((ext_vector_type(4)));
typedef unsigned v2u __attribute__((ext_vector_type(2)));
typedef float f32x4 __attribute__((ext_vector_type(4)));
typedef GAS unsigned gu32;
#define RLX_AGENT __ATOMIC_RELAXED, __HIP_MEMORY_SCOPE_AGENT
#define LDS_WAIT() asm volatile("s_waitcnt lgkmcnt(0)" ::: "memory")
#define VM_WAIT() asm volatile("s_waitcnt vmcnt(0)" ::: "memory")
__device__ __forceinline__ unsigned f2bf(float f) { unsigned u = __builtin_bit_cast(unsigned, f); return (u + 0x7fffu + ((u >> 16) & 1u)) >> 16; }
__device__ __forceinline__ unsigned pk2(float lo, float hi) { return f2bf(lo) | (f2bf(hi) << 16); }
__device__ __forceinline__ float bf2f(bf16 v) { return __uint_as_float(((unsigned)v) << 16); }

#define XB_TMO      128
#define XB_XCNT(j)  (256  + 64 * (j))
#define XB_XSUB(j)  (1280 + 64 * (j))
#define XB_XGEN(j)  (2304 + 64 * (j))
#define XB_TOP      3328
#define XB_TOPGEN   3392
#define XCD_BAR_WORDS 3456
#define XB_SPIN_CAP (1u << 18)
__device__ __forceinline__ unsigned xb_ld(unsigned* p)              { return __hip_atomic_load(p, __ATOMIC_RELAXED, __HIP_MEMORY_SCOPE_AGENT); }
__device__ __forceinline__ unsigned xb_add(unsigned* p, unsigned v) { return __hip_atomic_fetch_add(p, v, __ATOMIC_RELAXED, __HIP_MEMORY_SCOPE_AGENT); }
__device__ __forceinline__ unsigned xb_xcc_id() { return (unsigned)__builtin_amdgcn_s_getreg((3 << 11) | 20) & 0xFu; }
#define XB_SPIN(cond, bar) do { unsigned _sp = 0; while (cond) { __builtin_amdgcn_s_sleep(1); \
    if ((++_sp & 255u) == 0u) { if (xb_ld(&(bar)[XB_TMO])) break; if (_sp > XB_SPIN_CAP) { atomicAdd(&(bar)[XB_TMO], 1u); break; } } } } while (0)

struct XcdBarrier {
    unsigned* bar; unsigned x;
    volatile LAS unsigned* st;
};

__device__ __forceinline__ XcdBarrier xcd_barrier_post(unsigned* bar, volatile LAS unsigned* st) {
    XcdBarrier b; b.bar = bar; b.x = xb_xcc_id(); b.st = st;
    if (threadIdx.x == 0) (void)xb_add(&bar[XB_XCNT(b.x)], 1u);
    return b;
}
__device__ __forceinline__ void xcd_barrier_complete(unsigned* bar, unsigned x, unsigned& nloc, unsigned& nx) {
    const unsigned G = gridDim.x * gridDim.y * gridDim.z;
    unsigned sum, cnt, mine, sp = 0u;
    for (;;) {
        sum = 0u; cnt = 0u; mine = 0u;
#pragma unroll
        for (unsigned j = 0; j < 16; ++j) { const unsigned c = xb_ld(&bar[XB_XCNT(j)]); sum += c; cnt += (c > 0u) ? 1u : 0u; mine = (j == x) ? c : mine; }
        if (sum == G) break;
        __builtin_amdgcn_s_sleep(1);
        if ((++sp & 255u) == 0u) { if (xb_ld(&bar[XB_TMO])) break; if (sp > XB_SPIN_CAP) { atomicAdd(&bar[XB_TMO], 1u); break; } }
    }
    nloc = mine > 0u ? mine : 1u; nx = cnt > 0u ? cnt : 1u;
}

__device__ __forceinline__ void xcd_barrier(const XcdBarrier& b) {
    asm volatile("s_waitcnt vmcnt(0)" ::: "memory");
    __syncthreads();
    if (threadIdx.x == 0) {
        unsigned* bar = b.bar;
        __builtin_amdgcn_s_waitcnt(0);
        unsigned nloc = b.st[0], nx = b.st[1];
        if (nloc == 0u) { xcd_barrier_complete(bar, b.x, nloc, nx); b.st[0] = nloc; b.st[1] = nx; }
        const unsigned old = xb_add(&bar[XB_XSUB(b.x)], 1u);
        const unsigned gen = old / nloc;
        if (old + 1u == (gen + 1u) * nloc) {
            __builtin_amdgcn_fence(__ATOMIC_RELEASE, "agent");
            asm volatile("s_waitcnt vmcnt(0)" ::: "memory");
            const unsigned og = xb_add(&bar[XB_TOP], 1u);
            const unsigned tg = og / nx;
            if (og + 1u == (tg + 1u) * nx) xb_add(&bar[XB_TOPGEN], 1u);
            else XB_SPIN(xb_ld(&bar[XB_TOPGEN]) == tg, bar);
            __builtin_amdgcn_fence(__ATOMIC_ACQUIRE, "agent");
            xb_add(&bar[XB_XGEN(b.x)], 1u);
            asm volatile("s_waitcnt vmcnt(0)" ::: "memory");
        } else {
            XB_SPIN(xb_ld(&bar[XB_XGEN(b.x)]) == gen, bar);
            __builtin_amdgcn_fence(__ATOMIC_ACQUIRE, "agent");
            asm volatile("s_waitcnt vmcnt(0)" ::: "memory");
        }
    }
    __syncthreads();
}

struct Args { const float* in[22]; float* out; unsigned char* ws; int ph_lo, ph_hi; };
struct Frame {
    LAS unsigned char* lds;
    volatile LAS unsigned* MISC;
    gu32* ctl;
    unsigned char* ws;
    int tid, lane, wave;
    int vcu, G;
    float* out;
};

__device__ __forceinline__ float wave_sum(float v) {
#pragma unroll
    for (int o = 1; o < 64; o <<= 1) v += __shfl_xor(v, o);
    return v;
}
__device__ __forceinline__ float wave_max(float v) {
#pragma unroll
    for (int o = 1; o < 64; o <<= 1) v = fmaxf(v, __shfl_xor(v, o));
    return v;
}

template <int MODE>
__device__ __forceinline__ void p0_transpose_item(const float* W, int K, int N, bf16* WT, int row_off, LAS float* scr, int item, int lane) {
    const int nblk = N / 32, kb = item / nblk, nb = item % nblk, k0 = 64 * kb, n0 = 32 * nb;
#pragma unroll 8
    for (int i = 0; i < 32; ++i) { const int kk = 2 * i + (lane >> 5); scr[kk * 33 + (lane & 31)] = W[(size_t)(k0 + kk) * N + n0 + (lane & 31)]; }
    LDS_WAIT(); asm volatile("" ::: "memory");
    const int c = lane & 7;
#pragma unroll
    for (int j = 0; j < 4; ++j) { const int n = (lane >> 3) + 8 * j; const LAS float* s = scr + (8 * c) * 33 + n;
        v4u o; o.x = pk2(s[0 * 33], s[1 * 33]); o.y = pk2(s[2 * 33], s[3 * 33]); o.z = pk2(s[4 * 33], s[5 * 33]); o.w = pk2(s[6 * 33], s[7 * 33]);
        const int ng = n0 + n;
        const int drow = MODE == 0 ? row_off + ng : (MODE == 1 ? 32 * (ng >> 4) + (ng & 15) : 32 * (ng >> 4) + 16 + (ng & 15));
        *(GAS v4u*)(WT + (size_t)drow * K + k0 + 8 * c) = o; }
    LDS_WAIT(); asm volatile("" ::: "memory");
}

__device__ __forceinline__ void p0_prologue(Frame& F, const Args& A) {
    {
        LAS float* cact = (LAS float*)(F.lds + RING_OFF);
        LAS float* part = cact + 2048;
        for (int i = F.tid; i < 2 * D; i += NWAVES * 64) { const float cv = A.in[1][i]; cact[i] = cv / (1.0f + __expf(-cv)); }
        __syncthreads();
        for (int ch = blockIdx.x; ch < (NMOD * D) / 64; ch += F.G) {
            const int n0 = ch * 64; float a0 = 0.f, a1 = 0.f;
            const float* wp = A.in[2] + (size_t)(F.wave * 128) * (NMOD * D) + n0 + F.lane;
#pragma unroll 8
            for (int k = 0; k < 128; ++k) { const float w = wp[(size_t)k * (NMOD * D)]; a0 += cact[F.wave * 128 + k] * w; a1 += cact[D + F.wave * 128 + k] * w; }
            part[(F.wave * 2 + 0) * 64 + F.lane] = a0; part[(F.wave * 2 + 1) * 64 + F.lane] = a1;
            __syncthreads();
            if (F.tid < 128) { const int b = F.tid >> 6, l = F.tid & 63; float s = 0.f;
#pragma unroll
                for (int w = 0; w < 8; ++w) s += part[(w * 2 + b) * 64 + l];
                ((float*)(F.ws + WS_MOD))[b * (NMOD * D) + n0 + l] = s + A.in[3][n0 + l]; }
            __syncthreads();
        }
        __syncthreads();
    }
    LAS float* scr = (LAS float*)(F.lds + RING_OFF + F.wave * 16384);
    const int gw = F.vcu * NWAVES + F.wave, NGW = F.G * NWAVES;
    {
        bf16* WcT = (bf16*)(F.ws + WS_WCOMB); const float* pw = A.in[8]; const float* ps = A.in[9]; const float* wbp = A.in[11];
        for (int it = gw; it < (PW / 8) * (D / 64); it += NGW) {
            const int c0 = (it >> 4) * 8, n = (it & 15) * 64 + F.lane, g = c0 >> 7;
            float a[8];
#pragma unroll
            for (int i = 0; i < 8; ++i) a[i] = 0.f;
            for (int d = 0; d < PGW; ++d) { const float wv = wbp[(size_t)(g * PGW + d) * D + n] * ps[g * PGW + d];
#pragma unroll
                for (int i = 0; i < 8; ++i) a[i] += pw[(size_t)(g * PGW + (c0 & 127) + i) * PGW + d] * wv; }
            v4u o; o.x = pk2(a[0], a[1]); o.y = pk2(a[2], a[3]); o.z = pk2(a[4], a[5]); o.w = pk2(a[6], a[7]);
            *(v4u*)(WcT + (size_t)n * PW + c0) = o; }
    }
    {
        bf16* Wh = (bf16*)(F.ws + WS_WR); bf16* Wl = Wh + 48 * D; const float* w_rg = A.in[14]; const float* w_re = A.in[16];
        for (int i = gw * 64 + F.lane; i < 48 * D; i += NGW * 64) { const int n = i >> 10, k = i & (D - 1);
            const float w = n < 32 ? w_re[(size_t)k * NE + n] : (n < 36 ? w_rg[(size_t)k * 4 + (n - 32)] : 0.f);
            const unsigned hb = f2bf(w); const float hf = __uint_as_float(hb << 16);
            Wh[i] = (bf16)hb; Wl[i] = (bf16)f2bf(w - hf); }
    }
    constexpr int I_IN = (D / 64) * (INW / 32), I_BA = (AW / 64) * (D / 32), I_BP = (PW / 64) * (D / 32), I_OUT = (D / 64) * (D / 32);
    constexpr int I_EG = (D / 64) * (DE / 32), I_ED = (DE / 64) * (D / 32);
    constexpr int NITEMS = I_IN + I_BA + I_OUT + NE * (2 * I_EG + I_ED);
    bf16* WinT = (bf16*)(F.ws + WS_WIN); bf16* WbaT = (bf16*)(F.ws + WS_WBA); bf16* WoutT = (bf16*)(F.ws + WS_WOUT);
    bf16* WguT = (bf16*)(F.ws + WS_WGU); bf16* WdT = (bf16*)(F.ws + WS_WD);
    for (int it = gw; it < NITEMS; it += NGW) {
        int r = it;
        if (r < I_IN) { p0_transpose_item<0>(A.in[5], D, INW, WinT, 0, scr, r, F.lane); continue; } r -= I_IN;
        if (r < I_BA) { p0_transpose_item<0>(A.in[10], AW, D, WbaT, 0, scr, r, F.lane); continue; } r -= I_BA;
        if (r < I_OUT) { p0_transpose_item<0>(A.in[12], D, D, WoutT, 0, scr, r, F.lane); continue; } r -= I_OUT;
        if (r < NE * I_EG) { const int e = r / I_EG; p0_transpose_item<1>(A.in[18] + (size_t)e * D * DE, D, DE, WguT + (size_t)e * D * D, 0, scr, r % I_EG, F.lane); continue; } r -= NE * I_EG;
        if (r < NE * I_EG) { const int e = r / I_EG; p0_transpose_item<2>(A.in[19] + (size_t)e * D * DE, D, DE, WguT + (size_t)e * D * D, 0, scr, r % I_EG, F.lane); continue; } r -= NE * I_EG;
        { const int e = r / I_ED; p0_transpose_item<0>(A.in[20] + (size_t)e * DE * D, DE, D, WdT + (size_t)e * D * DE, 0, scr, r % I_ED, F.lane); }
    }
}

__device__ __forceinline__ void p1_hrows(Frame& F, const Args& A) {
    const int gw = F.vcu * NWAVES + F.wave, NGW = F.G * NWAVES;
    const float* mod = (const float*)(F.ws + WS_MOD); bf16* H = (bf16*)(F.ws + WS_H);
    for (int m0 = gw * 4; m0 < NTOK; m0 += NGW * 4) {
        const float* md = mod + (m0 / SEQ) * (NMOD * D);
        f32x4 v[4][4];
#pragma unroll
        for (int r = 0; r < 4; ++r) { const f32x4* xr = (const f32x4*)(A.in[0] + (size_t)(m0 + r) * D) + F.lane;
#pragma unroll
            for (int j = 0; j < 4; ++j) v[r][j] = xr[64 * j]; }
        float rstd[4];
#pragma unroll
        for (int r = 0; r < 4; ++r) { float ss = 0.f;
#pragma unroll
            for (int j = 0; j < 4; ++j) ss += (v[r][j].x * v[r][j].x + v[r][j].y * v[r][j].y) + (v[r][j].z * v[r][j].z + v[r][j].w * v[r][j].w);
            rstd[r] = 1.0f / sqrtf(wave_sum(ss) * (1.0f / D) + EPS); }
#pragma unroll
        for (int j = 0; j < 4; ++j) { const int col = 4 * F.lane + 256 * j;
            const f32x4 g = *(const f32x4*)(A.in[4] + col), sh = *(const f32x4*)(md + col), sc = *(const f32x4*)(md + D + col);
            const f32x4 gs = g * (sc + 1.0f);
#pragma unroll
            for (int r = 0; r < 4; ++r) { const f32x4 hh = (v[r][j] * rstd[r]) * gs + sh;
                v2u o; o.x = pk2(hh.x, hh.y); o.y = pk2(hh.z, hh.w);
                *(v2u*)(H + (size_t)(m0 + r) * D + col) = o; } }
    }
}

__device__ __forceinline__ void p3_pooldiff(Frame& F, const Args& A) {
    const int gw = F.vcu * NWAVES + F.wave, NGW = F.G * NWAVES, lane = F.lane;
    const bf16* Ut = (const bf16*)(F.ws + WS_PROJ) + (size_t)3 * NTOK * 512;
    bf16* DP = (bf16*)(F.ws + WS_DP);
    const int w = 2 << (lane >> 4);
    for (int m = gw; m < NTOK; m += NGW) {
        const int t = m & (SEQ - 1); const int cnt = (t + 1) < w ? (t + 1) : w;
        const bf16* up = Ut + (size_t)m * 512 + 8 * lane;
        const v4u u0 = *(const v4u*)up;
        float s[8] = {bf_lo(u0.x), bf_hi(u0.x), bf_lo(u0.y), bf_hi(u0.y), bf_lo(u0.z), bf_hi(u0.z), bf_lo(u0.w), bf_hi(u0.w)};
        float u[8];
#pragma unroll
        for (int i = 0; i < 8; ++i) u[i] = s[i];
        v4u vv[15];
#pragma unroll
        for (int k = 1; k < 16; ++k) { vv[k - 1] = (v4u){0u, 0u, 0u, 0u}; if (k < cnt) vv[k - 1] = *(const v4u*)(up - (size_t)k * 512); }
#pragma unroll
        for (int k = 1; k < 16; ++k) { const v4u v = vv[k - 1];
            s[0] += bf_lo(v.x); s[1] += bf_hi(v.x); s[2] += bf_lo(v.y); s[3] += bf_hi(v.y); s[4] += bf_lo(v.z); s[5] += bf_hi(v.z); s[6] += bf_lo(v.w); s[7] += bf_hi(v.w); }
        const float inv = 1.0f / (float)cnt;
        v4u o; o.x = pk2(s[0] * inv - u[0], s[1] * inv - u[1]); o.y = pk2(s[2] * inv - u[2], s[3] * inv - u[3]); o.z = pk2(s[4] * inv - u[4], s[5] * inv - u[5]); o.w = pk2(s[6] * inv - u[6], s[7] * inv - u[7]);
        *(v4u*)(DP + (size_t)m * 512 + 8 * lane) = o;
    }
}

__device__ __forceinline__ void build_btab(Frame& F, const Args& A) {
    LAS float* btab = (LAS float*)(F.lds + BTAB_OFF);
    for (int i = F.tid; i < NH * 128; i += NWAVES * 64) { const int h = i >> 7, rel = i & 127; int bk;
        if (rel < 16) bk = rel;
        else { bk = 16; const int th[15] = {19, 21, 24, 27, 31, 35, 40, 46, 52, 59, 67, 77, 87, 99, 113};
#pragma unroll
            for (int q = 0; q < 15; ++q) bk += (rel >= th[q]) ? 1 : 0; }
        btab[i] = A.in[7][bk * NH + h]; }
    __syncthreads();
}

__device__ __forceinline__ void p4_attn_naive(Frame& F, const Args& A) {
    build_btab(F, A);
    const int gw = F.vcu * NWAVES + F.wave, NGW = F.G * NWAVES;
    const bf16* Qt = (const bf16*)(F.ws + WS_PROJ);
    const bf16* Kt = Qt + (size_t)1 * NTOK * 512;
    const bf16* Vt = Qt + (size_t)2 * NTOK * 512;
    const float* kmean = (const float*)(F.ws + WS_KSUM);
    bf16* AO = (bf16*)(F.ws + WS_AO);
    const LAS float* btab = (const LAS float*)(F.lds + BTAB_OFF);
    LAS float* qs = (LAS float*)(F.lds + RING_OFF + F.wave * 8192);
    LAS float* ps = qs + 64;
    const int lane = F.lane;
    for (int it = gw; it < NTOK * NH; it += NGW) {
        const int h = it & 7, m = it >> 3, b = m / SEQ, t = m & (SEQ - 1), blk = t >> 8;
        qs[lane] = bf2f(Qt[(size_t)m * 512 + h * HD + lane]);
        LDS_WAIT(); asm volatile("" ::: "memory");
        float q[64];
#pragma unroll
        for (int d4 = 0; d4 < 16; ++d4) { const f32x4 v = *(const LAS f32x4*)(qs + 4 * d4); q[4 * d4] = v.x; q[4 * d4 + 1] = v.y; q[4 * d4 + 2] = v.z; q[4 * d4 + 3] = v.w; }
        float sc = -3.0e38f;
        if (lane < blk) { const f32x4* km = (const f32x4*)(kmean + (size_t)((b * NH + h) * NBLK + lane) * HD); float s = 0.f;
#pragma unroll
            for (int d4 = 0; d4 < 16; ++d4) { const f32x4 kv = km[d4]; s += q[4 * d4] * kv.x + q[4 * d4 + 1] * kv.y + q[4 * d4 + 2] * kv.z + q[4 * d4 + 3] * kv.w; }
            sc = s; }
        int sel[3];
#pragma unroll
        for (int i = 0; i < 3; ++i) { const float mx = wave_max(sc); const unsigned long long mk = __ballot(sc == mx && lane < blk);
            const int idx = mk ? (int)__builtin_ctzll(mk) : 0; sel[i] = idx; if (lane == idx) sc = -3.0e38f; }
        const int nsel = blk < 3 ? blk : 3;
        float lg[4][4];
#pragma unroll
        for (int s = 0; s < 4; ++s) {
            const bool valid = (s == 3) || (s < nsel);
            const int jb = (s == 3) ? blk : sel[s < 3 ? s : 0];
#pragma unroll
            for (int i = 0; i < 4; ++i) {
                float lgt = NEG_INF;
                if (valid) { const int kk = lane + 64 * i, kpos = jb * MBLK + kk;
                    const v4u* kr = (const v4u*)(Kt + (size_t)(b * SEQ + kpos) * 512 + h * HD); float dsum = 0.f;
#pragma unroll
                    for (int c8 = 0; c8 < 8; ++c8) { const v4u kv = kr[c8];
                        dsum += q[8 * c8 + 0] * __uint_as_float(kv.x << 16) + q[8 * c8 + 1] * __uint_as_float(kv.x & 0xffff0000u)
                              + q[8 * c8 + 2] * __uint_as_float(kv.y << 16) + q[8 * c8 + 3] * __uint_as_float(kv.y & 0xffff0000u)
                              + q[8 * c8 + 4] * __uint_as_float(kv.z << 16) + q[8 * c8 + 5] * __uint_as_float(kv.z & 0xffff0000u)
                              + q[8 * c8 + 6] * __uint_as_float(kv.w << 16) + q[8 * c8 + 7] * __uint_as_float(kv.w & 0xffff0000u); }
                    const int rel = t - kpos;
                    if (rel >= 0) lgt = dsum * 0.125f + btab[h * 128 + (rel > 127 ? 127 : rel)]; }
                lg[s][i] = lgt; }
        }
        float mx = NEG_INF;
#pragma unroll
        for (int s = 0; s < 4; ++s)
#pragma unroll
            for (int i = 0; i < 4; ++i) mx = fmaxf(mx, lg[s][i]);
        mx = wave_max(mx);
        float sum = 0.f;
#pragma unroll
        for (int s = 0; s < 4; ++s)
#pragma unroll
            for (int i = 0; i < 4; ++i) { const float e = (lg[s][i] <= -1e29f) ? 0.f : __expf(lg[s][i] - mx); lg[s][i] = e; sum += e; }
        sum = wave_sum(sum);
        const float inv = 1.0f / sum;
#pragma unroll
        for (int s = 0; s < 4; ++s)
#pragma unroll
            for (int i = 0; i < 4; ++i) ps[s * 256 + lane + 64 * i] = lg[s][i] * inv;
        LDS_WAIT(); asm volatile("" ::: "memory");
        float o = 0.f;
#pragma unroll
        for (int s = 0; s < 4; ++s) {
            const bool valid = (s == 3) || (s < nsel);
            if (valid) { const int jb = (s == 3) ? blk : sel[s < 3 ? s : 0];
                const int nk = (s == 3) ? (((t & 255) + 4) & ~3) : 256;
                const bf16* vp = Vt + (size_t)(b * SEQ + jb * MBLK) * 512 + h * HD + lane;
                for (int kk = 0; kk < nk; kk += 4) { const f32x4 p4 = *(const LAS f32x4*)(ps + s * 256 + kk);
                    o += p4.x * bf2f(vp[(size_t)(kk + 0) * 512]) + p4.y * bf2f(vp[(size_t)(kk + 1) * 512]) + p4.z * bf2f(vp[(size_t)(kk + 2) * 512]) + p4.w * bf2f(vp[(size_t)(kk + 3) * 512]); } }
        }
        AO[(size_t)m * 512 + h * HD + lane] = (bf16)f2bf(o);
        LDS_WAIT(); asm volatile("" ::: "memory");
    }
}

__device__ __forceinline__ void p8_norm_route(Frame& F, const Args& A) {
    typedef short bf16x8 __attribute__((ext_vector_type(8)));
    const int lane = F.lane, w = F.wave, tile = w >> 1, kh = w & 1, r = lane & 15, kg = lane >> 4;
    const float* mod = (const float*)(F.ws + WS_MOD); bf16* H2 = (bf16*)(F.ws + WS_H);
    int* route = (int*)(F.ws + WS_ROUTE); int* list = (int*)(F.ws + WS_LIST);
    const bf16* Wh = (const bf16*)(F.ws + WS_WR); const bf16* Wl = Wh + 48 * D;
    LAS float* avec = (LAS float*)(F.lds + RING_OFF); LAS float* cvec = avec + D; LAS float* ssp = cvec + D;
    LAS float* zt = ssp + 128;
    LAS int* lcnt = (LAS int*)(zt + 4 * 2 * 16 * 48); LAS int* gbase = lcnt + 32; LAS int* tinfo = gbase + 32;
    const float bias = lane < 32 ? A.in[17][lane] : (lane < 36 ? A.in[15][lane - 32] : 0.f);
    for (int wg = blockIdx.x; wg < NTOK / 64; wg += F.G) {
        const int mbase = wg * 64; const float* md = mod + (mbase / SEQ) * (NMOD * D);
        __syncthreads();
        for (int k = F.tid; k < D; k += NWAVES * 64) { avec[k] = A.in[13][k] * (1.0f + md[4 * D + k]); cvec[k] = md[3 * D + k]; }
        if (F.tid < 32) lcnt[F.tid] = 0;
        const int m = mbase + 16 * tile + r;
        const f32x4* xr = (const f32x4*)(F.out + (size_t)m * D + kh * 512 + 8 * kg);
        f32x4 xa[16], xb[16]; float ss = 0.f;
#pragma unroll
        for (int ks = 0; ks < 16; ++ks) { xa[ks] = xr[8 * ks]; xb[ks] = xr[8 * ks + 1]; }
#pragma unroll
        for (int ks = 0; ks < 16; ++ks) ss += (xa[ks].x * xa[ks].x + xa[ks].y * xa[ks].y) + (xa[ks].z * xa[ks].z + xa[ks].w * xa[ks].w) + (xb[ks].x * xb[ks].x + xb[ks].y * xb[ks].y) + (xb[ks].z * xb[ks].z + xb[ks].w * xb[ks].w);
        ss += __shfl_xor(ss, 16); ss += __shfl_xor(ss, 32);
        if (kg == 0) ssp[w * 16 + r] = ss;
        __syncthreads();
        const float rstd = 1.0f / sqrtf((ssp[w * 16 + r] + ssp[(w ^ 1) * 16 + r]) * (1.0f / D) + EPS);
        f32x4 acc[3];
#pragma unroll
        for (int nt = 0; nt < 3; ++nt) acc[nt] = (f32x4){0.f, 0.f, 0.f, 0.f};
        const int kl = kh * 512 + 8 * kg;
        const bf16* wbh[3]; const bf16* wbl[3];
#pragma unroll
        for (int nt = 0; nt < 3; ++nt) { wbh[nt] = Wh + (size_t)(16 * nt + r) * D + kl; wbl[nt] = Wl + (size_t)(16 * nt + r) * D + kl; }
        bf16* h2p = H2 + (size_t)m * D + kl; const LAS float* ap = avec + kl; const LAS float* cp = cvec + kl;
#pragma unroll
        for (int ks = 0; ks < 16; ++ks) {
            if ((ks & 1) == 0) asm volatile("" ::: "memory");
            const f32x4 a0 = *(const LAS f32x4*)(ap + 32 * ks), a1 = *(const LAS f32x4*)(ap + 32 * ks + 4), c0 = *(const LAS f32x4*)(cp + 32 * ks), c1 = *(const LAS f32x4*)(cp + 32 * ks + 4);
            const f32x4 h0 = (xa[ks] * rstd) * a0 + c0, h1 = (xb[ks] * rstd) * a1 + c1;
            v4u hb; hb.x = pk2(h0.x, h0.y); hb.y = pk2(h0.z, h0.w); hb.z = pk2(h1.x, h1.y); hb.w = pk2(h1.z, h1.w);
            *(v4u*)(h2p + 32 * ks) = hb;
            v4u lb; lb.x = pk2(h0.x - bf_lo(hb.x), h0.y - bf_hi(hb.x)); lb.y = pk2(h0.z - bf_lo(hb.y), h0.w - bf_hi(hb.y)); lb.z = pk2(h1.x - bf_lo(hb.z), h1.y - bf_hi(hb.z)); lb.w = pk2(h1.z - bf_lo(hb.w), h1.w - bf_hi(hb.w));
            const bf16x8 ah = __builtin_bit_cast(bf16x8, hb), al = __builtin_bit_cast(bf16x8, lb);
#pragma unroll
            for (int nt = 0; nt < 3; ++nt) { const bf16x8 bh = *(const bf16x8*)(wbh[nt] + 32 * ks), bl = *(const bf16x8*)(wbl[nt] + 32 * ks);
                acc[nt] = __builtin_amdgcn_mfma_f32_16x16x32_bf16(ah, bh, acc[nt], 0, 0, 0);
                acc[nt] = __builtin_amdgcn_mfma_f32_16x16x32_bf16(ah, bl, acc[nt], 0, 0, 0);
                acc[nt] = __builtin_amdgcn_mfma_f32_16x16x32_bf16(al, bh, acc[nt], 0, 0, 0); } }
#pragma unroll
        for (int nt = 0; nt < 3; ++nt)
#pragma unroll
            for (int q = 0; q < 4; ++q) zt[((tile * 2 + kh) * 16 + 4 * kg + q) * 48 + 16 * nt + r] = acc[nt][q];
        __syncthreads();
#pragma unroll 1
        for (int i = 0; i < 8; ++i) { const int tok = 8 * w + i, tt = tok >> 4, tr = tok & 15, lz = lane < 48 ? lane : 47;
            const float z = zt[((tt * 2 + 0) * 16 + tr) * 48 + lz] + zt[((tt * 2 + 1) * 16 + tr) * 48 + lz] + bias;
            const bool isg = lane >= 32 && lane < 36;
            const float vg = isg ? z : -3.0e38f;
            const float gm = wave_max(vg);
            const int gi = (int)__builtin_ctzll(__ballot(isg && vg == gm)) - 32;
            const float gs = wave_sum(isg ? __expf(vg - gm) : 0.f);
            const float pg = 1.0f / gs;
            const bool ing = lane < 32 && (lane >> 3) == gi;
            const float ve = ing ? z : -3.0e38f;
            const float e0m = wave_max(ve);
            const int ex0 = (int)__builtin_ctzll(__ballot(ing && ve == e0m));
            const float ve2 = (lane == ex0) ? -3.0e38f : ve;
            const float e1m = wave_max(ve2);
            const int ex1 = (int)__builtin_ctzll(__ballot(ing && lane != ex0 && ve2 == e1m));
            const float e1 = __expf(e1m - e0m); const float w0 = pg / (1.0f + e1), w1 = pg * e1 / (1.0f + e1);
            if (lane == 0) { const int lp0 = __hip_atomic_fetch_add(lcnt + ex0, 1, __ATOMIC_RELAXED, __HIP_MEMORY_SCOPE_WORKGROUP), lp1 = __hip_atomic_fetch_add(lcnt + ex1, 1, __ATOMIC_RELAXED, __HIP_MEMORY_SCOPE_WORKGROUP);
                LAS int* ti = tinfo + tok * 8; ti[0] = ex0; ti[1] = ex1; ti[2] = lp0; ti[3] = lp1; ti[4] = __float_as_int(w0); ti[5] = __float_as_int(w1); } }
        __syncthreads();
        if (F.tid < 32) { const int c = lcnt[F.tid]; gbase[F.tid] = c ? (int)__hip_atomic_fetch_add((unsigned*)(F.ctl + CW_ECNT + 64 * F.tid), (unsigned)c, RLX_AGENT) : 0; }
        __syncthreads();
        if (F.tid < 64) { const LAS int* ti = tinfo + F.tid * 8; const int ex0 = ti[0], ex1 = ti[1], p0 = gbase[ex0] + ti[2], p1 = gbase[ex1] + ti[3], mm = mbase + F.tid;
            list[(size_t)ex0 * NTOK + p0] = mm; list[(size_t)ex1 * NTOK + p1] = mm;
            int* rt = route + (size_t)mm * 8; rt[0] = ex0; rt[1] = ex1; rt[2] = p0; rt[3] = p1; rt[4] = ti[4]; rt[5] = ti[5]; }
    }
    __syncthreads();
}

__device__ __forceinline__ void build_tables(Frame& F) {
    LAS int* toff = (LAS int*)(F.lds + TOFF_OFF); LAS int* ecnt = (LAS int*)(F.lds + ECNT_OFF); LAS int* tile_e = (LAS int*)(F.lds + TILEE_OFF);
    __syncthreads();
    if (F.tid < NE) ecnt[F.tid] = (int)__hip_atomic_load((unsigned*)(F.ctl + CW_ECNT + 64 * F.tid), RLX_AGENT);
    __syncthreads();
    if (F.tid == 0) { int o = 0; for (int e = 0; e < NE; ++e) { toff[e] = o; const int nt = (ecnt[e] + 255) >> 8; for (int k = 0; k < nt; ++k) tile_e[o + k] = e; o += nt; } toff[NE] = o; }
    __syncthreads();
}

__device__ __forceinline__ void p8_gather(Frame& F, const Args& A) {
    build_tables(F);
    const int gw = F.vcu * NWAVES + F.wave, NGW = F.G * NWAVES;
    const LAS int* toff = (const LAS int*)(F.lds + TOFF_OFF); const LAS int* ecnt = (const LAS int*)(F.lds + ECNT_OFF); const LAS int* tile_e = (const LAS int*)(F.lds + TILEE_OFF);
    const bf16* H2 = (const bf16*)(F.ws + WS_H); bf16* XG = (bf16*)(F.ws + WS_XG); const int* list = (const int*)(F.ws + WS_LIST);
    const int nrows = toff[NE] * 256;
    for (int r = gw; r < nrows; r += NGW) {
        const int e = tile_e[r >> 8], p = r - toff[e] * 256;
        v4u a = (v4u){0u, 0u, 0u, 0u}, bq = a;
        if (p < ecnt[e]) { const int tok = list[(size_t)e * NTOK + p]; const v4u* src = (const v4u*)(H2 + (size_t)tok * D); a = src[F.lane]; bq = src[F.lane + 64]; }
        v4u* dst = (v4u*)(XG + (size_t)r * D); dst[F.lane] = a; dst[F.lane + 64] = bq;
    }
}

__device__ __forceinline__ void p11_final(Frame& F, const Args& A) {
    build_tables(F);
    const int gw = F.vcu * NWAVES + F.wave, NGW = F.G * NWAVES;
    const LAS int* toff = (const LAS int*)(F.lds + TOFF_OFF);
    const float* mod = (const float*)(F.ws + WS_MOD); const bf16* Y = (const bf16*)(F.ws + WS_Y); const int* route = (const int*)(F.ws + WS_ROUTE);
    for (int m0 = gw * 4; m0 < NTOK; m0 += NGW * 4) {
        const float* md = mod + (m0 / SEQ) * (NMOD * D);
        size_t r0[4], r1[4]; float w0[4], w1[4];
#pragma unroll
        for (int r = 0; r < 4; ++r) { const v4u ra = *(const v4u*)(route + (size_t)(m0 + r) * 8); const v2u rb = *(const v2u*)(route + (size_t)(m0 + r) * 8 + 4);
            r0[r] = (size_t)toff[ra.x] * 256 + ra.z; r1[r] = (size_t)toff[ra.y] * 256 + ra.w; w0[r] = __uint_as_float(rb.x); w1[r] = __uint_as_float(rb.y); }
        f32x4 v[4][4]; v2u ya[4][4], yb[4][4];
#pragma unroll
        for (int r = 0; r < 4; ++r) { const f32x4* xr = (const f32x4*)(F.out + (size_t)(m0 + r) * D) + F.lane;
#pragma unroll
            for (int j = 0; j < 4; ++j) { const int col = 4 * F.lane + 256 * j; v[r][j] = xr[64 * j]; ya[r][j] = *(const v2u*)(Y + r0[r] * D + col); yb[r][j] = *(const v2u*)(Y + r1[r] * D + col); } }
        float rstd[4];
#pragma unroll
        for (int r = 0; r < 4; ++r) { float ss = 0.f;
#pragma unroll
            for (int j = 0; j < 4; ++j) { const int col = 4 * F.lane + 256 * j; const f32x4 g2 = *(const f32x4*)(md + 5 * D + col); const v2u y0 = ya[r][j], y1 = yb[r][j];
                f32x4 yy; yy.x = w0[r] * bf_lo(y0.x) + w1[r] * bf_lo(y1.x); yy.y = w0[r] * bf_hi(y0.x) + w1[r] * bf_hi(y1.x); yy.z = w0[r] * bf_lo(y0.y) + w1[r] * bf_lo(y1.y); yy.w = w0[r] * bf_hi(y0.y) + w1[r] * bf_hi(y1.y);
                v[r][j] = v[r][j] + g2 * yy;
                ss += (v[r][j].x * v[r][j].x + v[r][j].y * v[r][j].y) + (v[r][j].z * v[r][j].z + v[r][j].w * v[r][j].w); }
            rstd[r] = 1.0f / sqrtf(wave_sum(ss) * (1.0f / D) + EPS); }
#pragma unroll
        for (int j = 0; j < 4; ++j) { const int col = 4 * F.lane + 256 * j; const f32x4 g = *(const f32x4*)(A.in[21] + col);
#pragma unroll
            for (int r = 0; r < 4; ++r) *((f32x4*)(F.out + (size_t)(m0 + r) * D) + F.lane + 64 * j) = (v[r][j] * rstd[r]) * g; }
    }
}


namespace att {
typedef float f32x16 __attribute__((ext_vector_type(16)));
typedef short bf16x8 __attribute__((ext_vector_type(8)));
typedef short s16x4 __attribute__((ext_vector_type(4)));
typedef short v4i16_t __attribute__((ext_vector_type(4)));
constexpr float LOG2E = 1.4426950408889634f, C2 = 0.125f * LOG2E;
constexpr int KIMG = 0, VIMG = 32768, LIST_OFF = 65536, CNT_OFF = 73728, WSF_OFF = 73728 + 256;
constexpr size_t PLANE = (size_t)NTOK * NH * HD;
__device__ __forceinline__ int crow(int r, int hi) { return (r & 3) + 8 * (r >> 2) + 4 * hi; }
__device__ __forceinline__ s16x4 vtr(const LAS unsigned char* p) { return __builtin_bit_cast(s16x4, __builtin_amdgcn_ds_read_tr16_b64_v4i16((LAS v4i16_t*)p)); }
__device__ __forceinline__ float swap_max(float v) { auto rr = __builtin_amdgcn_permlane32_swap(__float_as_uint(v), __float_as_uint(v), false, false); return fmaxf(__uint_as_float(rr[0]), __uint_as_float(rr[1])); }
__device__ __forceinline__ float swap_sum(float v) { auto rr = __builtin_amdgcn_permlane32_swap(__float_as_uint(v), __float_as_uint(v), false, false); return __uint_as_float(rr[0]) + __uint_as_float(rr[1]); }

__device__ __forceinline__ void load_kv(LAS unsigned char* lds, const bf16* Kt, const bf16* Vt, int b, int h, int jb, int tid, int wave) {
    const bf16* kb = Kt + (size_t)(b * SEQ + jb * MBLK) * 512 + h * HD;
    const bf16* vb = Vt + (size_t)(b * SEQ + jb * MBLK) * 512 + h * HD;
#pragma unroll
    for (int i = 0; i < 4; ++i) { const int g = tid + 512 * i, row = g >> 3, cp = g & 7;
        const int ck = cp ^ ((row >> 1) & 7);
        __builtin_amdgcn_global_load_lds((const unsigned*)(kb + (size_t)row * 512 + ck * 8), (LAS unsigned*)(lds + KIMG + wave * 1024 + i * 8192), 16, 0, 0);
        const int dv = (((cp >> 2) ^ ((row >> 1) & 1)) << 5) + ((cp & 3) << 3);
        __builtin_amdgcn_global_load_lds((const unsigned*)(vb + (size_t)row * 512 + dv), (LAS unsigned*)(lds + VIMG + wave * 1024 + i * 8192), 16, 0, 0); }
}

__device__ __forceinline__ void qk_tile(f32x16& S, const LAS unsigned char* lds, int kt, const int (&kb)[4], const bf16x8 (&qr)[4]) {
    f32x16 acc = {};
#pragma unroll
    for (int d0 = 0; d0 < 4; ++d0) { const bf16x8 kf = *(const LAS bf16x8*)(lds + KIMG + kt * 4096 + kb[d0]); acc = __builtin_amdgcn_mfma_f32_32x32x16_bf16(kf, qr[d0], acc, 0, 0, 0); }
    S = acc;
}
__device__ __forceinline__ bf16x8 pack_p(const f32x16& P, int s) {
    pg8::u32x4 w; w.x = pg8::cvt_pk_bf16(P[8 * s + 0], P[8 * s + 1]); w.y = pg8::cvt_pk_bf16(P[8 * s + 2], P[8 * s + 3]); w.z = pg8::cvt_pk_bf16(P[8 * s + 4], P[8 * s + 5]); w.w = pg8::cvt_pk_bf16(P[8 * s + 6], P[8 * s + 7]);
    return __builtin_bit_cast(bf16x8, w);
}
__device__ __forceinline__ void pv_tile(f32x16& o0, f32x16& o1, const f32x16& P, const LAS unsigned char* lds, int kt, int vb0, int vb1) {
#pragma unroll
    for (int s = 0; s < 2; ++s) { const bf16x8 pa = pack_p(P, s); const int off = VIMG + (32 * kt + 16 * s) * 128;
        const s16x4 l0 = vtr(lds + off + vb0), h0 = vtr(lds + off + 1024 + vb0), l1 = vtr(lds + off + vb1), h1 = vtr(lds + off + 1024 + vb1);
        const bf16x8 b0 = (bf16x8){l0[0], l0[1], l0[2], l0[3], h0[0], h0[1], h0[2], h0[3]}, b1 = (bf16x8){l1[0], l1[1], l1[2], l1[3], h1[0], h1[1], h1[2], h1[3]};
        o0 = __builtin_amdgcn_mfma_f32_32x32x16_bf16(b0, pa, o0, 0, 0, 0); o1 = __builtin_amdgcn_mfma_f32_32x32x16_bf16(b1, pa, o1, 0, 0, 0); }
}

struct SelUnit { unsigned char j, qlo, qhi, pad; };
constexpr int SU_MAX = 192;
struct SelTable { SelUnit u[SU_MAX]; int n; };
constexpr float su_expect(int qb) { return 256.f * (qb < 3 ? (float)qb : 3.f) / (float)qb; }
constexpr SelTable make_sel_table() {
    SelTable T{}; float ex[SU_MAX] = {}; int n = 0;
    for (int j = 0; j < NBLK - 1; ++j) { int qb = j + 1;
        while (qb < NBLK) { const int lo = qb; float acc = 0.f;
            while (qb < NBLK && (qb - lo) < 16) { const float e = su_expect(qb); if (acc > 0.f && acc + e > 640.f) break; acc += e; ++qb; if (acc >= 512.f) break; }
            T.u[n].j = (unsigned char)j; T.u[n].qlo = (unsigned char)lo; T.u[n].qhi = (unsigned char)qb; T.u[n].pad = 0; ex[n] = acc; ++n; } }
    for (int i = 1; i < n; ++i) { const SelUnit u = T.u[i]; const float e = ex[i]; int k = i - 1; while (k >= 0 && ex[k] < e) { T.u[k + 1] = T.u[k]; ex[k + 1] = ex[k]; --k; } T.u[k + 1] = u; ex[k + 1] = e; }
    T.n = n; return T;
}
__device__ const SelTable g_seltab = make_sel_table();
}

__device__ __forceinline__ void p3_route(Frame& F) {
    const bf16* Qt = (const bf16*)(F.ws + WS_PROJ);
    const float* ksum = (const float*)(F.ws + WS_KSUM);
    unsigned* SEL = (unsigned*)(F.ws + WS_LIST);
    LAS float* ks = (LAS float*)(F.lds + RING_OFF);
    for (int w = blockIdx.x; w < 256; w += F.G) {
        const int bh = w >> 4, b = bh >> 3, h = bh & 7, t = (w & 15) * 512 + F.tid, blk = t >> 8;
        __syncthreads();
        { const f32x4 v = *(const f32x4*)(ksum + (size_t)bh * NBLK * HD + 4 * F.tid); *(LAS f32x4*)(ks + 4 * F.tid) = v; }
        __syncthreads();
        float q[64];
        { const v4u* qp = (const v4u*)(Qt + (size_t)(b * SEQ + t) * 512 + h * HD);
#pragma unroll
          for (int c8 = 0; c8 < 8; ++c8) { const v4u v = qp[c8]; q[8 * c8] = bf_lo(v.x); q[8 * c8 + 1] = bf_hi(v.x); q[8 * c8 + 2] = bf_lo(v.y); q[8 * c8 + 3] = bf_hi(v.y); q[8 * c8 + 4] = bf_lo(v.z); q[8 * c8 + 5] = bf_hi(v.z); q[8 * c8 + 6] = bf_lo(v.w); q[8 * c8 + 7] = bf_hi(v.w); } }
        float v0 = -3.0e38f, v1 = -3.0e38f, v2 = -3.0e38f; unsigned i0 = 255u, i1 = 255u, i2 = 255u;
        for (int j = 0; j < blk; ++j) { float s = 0.f;
#pragma unroll
            for (int d4 = 0; d4 < 16; ++d4) { const f32x4 kv = *(const LAS f32x4*)(ks + j * HD + 4 * d4); s += q[4 * d4] * kv.x + q[4 * d4 + 1] * kv.y + q[4 * d4 + 2] * kv.z + q[4 * d4 + 3] * kv.w; }
            if (s > v0) { v2 = v1; i2 = i1; v1 = v0; i1 = i0; v0 = s; i0 = (unsigned)j; }
            else if (s > v1) { v2 = v1; i2 = i1; v1 = s; i1 = (unsigned)j; }
            else if (s > v2) { v2 = s; i2 = (unsigned)j; } }
        SEL[(size_t)bh * SEQ + t] = i0 | (i1 << 8) | (i2 << 16) | 0xFF000000u;
    }
}

__device__ __forceinline__ void build_btab8(Frame& F, const Args& A, int h) {
    LAS float* btab = (LAS float*)(F.lds + BTAB_OFF);
    if (F.tid < 128) { const int rel = F.tid; int bk;
        if (rel < 16) bk = rel;
        else { bk = 16; const int th[15] = {19, 21, 24, 27, 31, 35, 40, 46, 52, 59, 67, 77, 87, 99, 113};
#pragma unroll
            for (int q = 0; q < 15; ++q) bk += (rel >= th[q]) ? 1 : 0; }
        btab[rel] = 8.0f * A.in[7][bk * NH + h]; }
    __syncthreads();
}

__device__ __forceinline__ void p4_selected(Frame& F, const Args& A) {
    using namespace att;
    const bf16* Qt = (const bf16*)(F.ws + WS_PROJ); const bf16* Kt = Qt + (size_t)1 * NTOK * 512; const bf16* Vt = Qt + (size_t)2 * NTOK * 512;
    const unsigned* SEL = (const unsigned*)(F.ws + WS_LIST);
    bf16* PO = (bf16*)F.out; float* PL = (float*)((unsigned char*)F.out + 3 * PLANE * 2);
    LAS unsigned char* lds = F.lds + RING_OFF;
    LAS unsigned short* list = (LAS unsigned short*)(lds + LIST_OFF); LAS unsigned* cntw = (LAS unsigned*)(lds + CNT_OFF);
    LAS float* wsf = (LAS float*)(lds + WSF_OFF + F.wave * 1024);
    const LAS float* btab = (const LAS float*)(F.lds + BTAB_OFF);
    const int lane = F.lane, r32 = lane & 31, hi = lane >> 5;
    const int swz = (r32 >> 1) & 7; int kb[4];
#pragma unroll
    for (int d0 = 0; d0 < 4; ++d0) kb[d0] = r32 * 128 + (((2 * d0 + hi) ^ swz) << 4);
    const int q_ = (lane & 15) >> 2, p_ = lane & 3, g1 = (lane >> 4) & 1;
    const int vb0 = (4 * hi + q_) * 128 + ((0 ^ (q_ >> 1)) << 6) + (16 * g1 + 4 * p_) * 2, vb1 = (4 * hi + q_) * 128 + ((1 ^ (q_ >> 1)) << 6) + (16 * g1 + 4 * p_) * 2;
    const int nunits = g_seltab.n * 16;
    int hprev = -1;
    for (int uidx = blockIdx.x; uidx < nunits; uidx += F.G) {
        const int ui = uidx >> 4, bh = uidx & 15, b = bh >> 3, h = bh & 7;
        const int j = g_seltab.u[ui].j, qlo = g_seltab.u[ui].qlo, qhi = g_seltab.u[ui].qhi;
        __syncthreads();
        if (h != hprev) { build_btab8(F, A, h); hprev = h; }
        unsigned swv[8];
#pragma unroll
        for (int c = 0; c < 8; ++c) { const int t = qlo * MBLK + c * 512 + F.tid; swv[c] = (t < qhi * MBLK) ? SEL[(size_t)bh * SEQ + t] : 0xFFFFFFFFu; }
        load_kv(lds, Kt, Vt, b, h, j, F.tid, F.wave);
        if (F.tid == 0) *cntw = 0u;
        asm volatile("s_waitcnt lgkmcnt(0)" ::: "memory");
        __builtin_amdgcn_s_barrier();
#pragma unroll
        for (int c = 0; c < 8; ++c) { const int t = qlo * MBLK + c * 512 + F.tid; const unsigned sw = swv[c];
            if (qlo * MBLK + c * 512 < qhi * MBLK) {
                const int slot = (t < qhi * MBLK) ? (((sw & 255u) == (unsigned)j) ? 0 : ((((sw >> 8) & 255u) == (unsigned)j) ? 1 : ((((sw >> 16) & 255u) == (unsigned)j) ? 2 : -1))) : -1;
                const unsigned long long mk = __ballot(slot >= 0);
                if (mk) { unsigned base = 0u; if (lane == 0) base = __hip_atomic_fetch_add(cntw, (unsigned)__builtin_popcountll(mk), __ATOMIC_RELAXED, __HIP_MEMORY_SCOPE_WORKGROUP);
                    base = (unsigned)__builtin_amdgcn_readfirstlane((int)base);
                    if (slot >= 0) list[base + (unsigned)__builtin_popcountll(mk & ((1ull << lane) - 1ull))] = (unsigned short)(t | (slot << 13)); } } }
        asm volatile("s_waitcnt vmcnt(0) lgkmcnt(0)" ::: "memory");
        __syncthreads();
        const int cnt = (int)*cntw, ntiles = (cnt + 31) >> 5;
        if (F.tid < 32 && cnt > 0) { const int idx = cnt + F.tid; if (idx < ntiles * 32) list[idx] = list[cnt - 1]; }
        __syncthreads();
        const float b31 = btab[127] * (0.125f * LOG2E);
        for (int tile = F.wave; tile < ntiles; tile += NWAVES) {
            const int ent = list[tile * 32 + r32]; const int tq = ent & 8191, slot = ent >> 13;
            bf16x8 qr[4];
            { const bf16* qp = Qt + (size_t)(b * SEQ + tq) * 512 + h * HD + 8 * hi;
#pragma unroll
              for (int d0 = 0; d0 < 4; ++d0) qr[d0] = *(const bf16x8*)(qp + 16 * d0); }
            f32x16 S[8];
#pragma unroll
            for (int kt = 0; kt < 8; ++kt) qk_tile(S[kt], lds, kt, kb, qr);
            const bool near = __ballot(tq < MBLK * (j + 1) + 112) != 0ull;
            if (near) {
#pragma unroll
                for (int kt = 0; kt < 8; ++kt)
#pragma unroll
                    for (int r = 0; r < 16; ++r) { const int rel = tq - (MBLK * j + 32 * kt + crow(r, hi)); S[kt][r] += btab[rel > 127 ? 127 : rel]; } }
            float mx = S[0][0];
#pragma unroll
            for (int kt = 0; kt < 8; ++kt)
#pragma unroll
                for (int r = 0; r < 16; ++r) mx = fmaxf(mx, S[kt][r]);
            mx = swap_max(mx);
            const float nm = -mx * C2; float l = 0.f;
#pragma unroll
            for (int kt = 0; kt < 8; ++kt)
#pragma unroll
                for (int r = 0; r < 16; ++r) { const float p = __builtin_amdgcn_exp2f(__builtin_fmaf(S[kt][r], C2, nm)); S[kt][r] = p; l += p; }
            l = swap_sum(l);
            f32x16 o0 = {}, o1 = {};
#pragma unroll
            for (int kt = 0; kt < 8; ++kt) pv_tile(o0, o1, S[kt], lds, kt, vb0, vb1);
            if (tile * 32 + r32 < cnt) { const float rl = 1.0f / l;
                bf16* dst = PO + (size_t)slot * PLANE + ((size_t)bh * SEQ + tq) * HD + 4 * hi;
#pragma unroll
                for (int g = 0; g < 4; ++g) { v2u wa, wb; wa.x = pk2(o0[4 * g] * rl, o0[4 * g + 1] * rl); wa.y = pk2(o0[4 * g + 2] * rl, o0[4 * g + 3] * rl);
                    wb.x = pk2(o1[4 * g] * rl, o1[4 * g + 1] * rl); wb.y = pk2(o1[4 * g + 2] * rl, o1[4 * g + 3] * rl);
                    *(v2u*)(dst + 8 * g) = wa; *(v2u*)(dst + 32 + 8 * g) = wb; }
                if (hi == 0) PL[((size_t)bh * SEQ + tq) * 4 + slot] = mx * C2 + (near ? 0.f : b31) + __builtin_amdgcn_logf(l); }
        }
    }
    __syncthreads();
}

__device__ __forceinline__ void own_tile(const LAS unsigned char* lds, const LAS float* btab, int bh, int qb, int wt, const bf16* Qt, const bf16* PO, const float* PL, bf16* AO,
                                         const int (&kb)[4], int vb0, int vb1, int r32, int hi) {
    using namespace att;
    const int b = bh >> 3, h = bh & 7, tq = qb * MBLK + 32 * wt + r32;
    bf16x8 qr[4];
    { const bf16* qp = Qt + (size_t)(b * SEQ + tq) * 512 + h * HD + 8 * hi;
#pragma unroll
      for (int d0 = 0; d0 < 4; ++d0) qr[d0] = *(const bf16x8*)(qp + 16 * d0); }
    const int nsel = qb < 3 ? qb : 3; const size_t qrow = (size_t)bh * SEQ + tq;
    f32x4 ls = (f32x4){0.f, 0.f, 0.f, 0.f};
    if (nsel > 0) ls = *(const f32x4*)(PL + qrow * 4);
    float mx = -INFINITY;
#pragma unroll 1
    for (int kt = 0; kt <= wt; ++kt) { f32x16 S; qk_tile(S, lds, kt, kb, qr);
#pragma unroll
        for (int r = 0; r < 16; ++r) { const int rel = (32 * wt + r32) - (32 * kt + crow(r, hi));
            const float v = rel < 0 ? -INFINITY : S[r] + btab[rel > 127 ? 127 : rel]; mx = fmaxf(mx, v); } }
    mx = swap_max(mx);
    const float nm = -mx * C2; float l = 0.f;
    f32x16 o0 = {}, o1 = {};
#pragma unroll 1
    for (int kt = 0; kt <= wt; ++kt) { f32x16 S; qk_tile(S, lds, kt, kb, qr);
#pragma unroll
        for (int r = 0; r < 16; ++r) { const int rel = (32 * wt + r32) - (32 * kt + crow(r, hi));
            const float v = rel < 0 ? -INFINITY : S[r] + btab[rel > 127 ? 127 : rel];
            const float p = __builtin_amdgcn_exp2f(__builtin_fmaf(v, C2, nm)); S[r] = p; l += p; }
        pv_tile(o0, o1, S, lds, kt, vb0, vb1); }
    l = swap_sum(l);
    const float mo = mx * C2;
    const float ls0 = nsel > 0 ? ls.x : -INFINITY, ls1 = nsel > 1 ? ls.y : -INFINITY, ls2 = nsel > 2 ? ls.z : -INFINITY;
    const float M = fmaxf(fmaxf(mo, ls0), fmaxf(ls1, ls2));
    const float wo = __builtin_amdgcn_exp2f(mo - M), w0 = __builtin_amdgcn_exp2f(ls0 - M), w1 = __builtin_amdgcn_exp2f(ls1 - M), w2 = __builtin_amdgcn_exp2f(ls2 - M);
    const float inv = 1.0f / (l * wo + w0 + w1 + w2);
    const float fo = wo * inv, f0 = w0 * inv, f1 = w1 * inv, f2 = w2 * inv;
    const bf16* pp = PO + qrow * HD + 4 * hi;
    bf16* dst = AO + (size_t)(b * SEQ + tq) * 512 + h * HD + 4 * hi;
#pragma unroll
    for (int g = 0; g < 4; ++g) {
        float a[8];
#pragma unroll
        for (int i = 0; i < 4; ++i) { a[i] = o0[4 * g + i] * fo; a[4 + i] = o1[4 * g + i] * fo; }
        if (nsel > 0) { const v2u x = *(const v2u*)(pp + 8 * g), y = *(const v2u*)(pp + 32 + 8 * g);
            a[0] += f0 * bf_lo(x.x); a[1] += f0 * bf_hi(x.x); a[2] += f0 * bf_lo(x.y); a[3] += f0 * bf_hi(x.y); a[4] += f0 * bf_lo(y.x); a[5] += f0 * bf_hi(y.x); a[6] += f0 * bf_lo(y.y); a[7] += f0 * bf_hi(y.y); }
        if (nsel > 1) { const v2u x = *(const v2u*)(pp + PLANE + 8 * g), y = *(const v2u*)(pp + PLANE + 32 + 8 * g);
            a[0] += f1 * bf_lo(x.x); a[1] += f1 * bf_hi(x.x); a[2] += f1 * bf_lo(x.y); a[3] += f1 * bf_hi(x.y); a[4] += f1 * bf_lo(y.x); a[5] += f1 * bf_hi(y.x); a[6] += f1 * bf_lo(y.y); a[7] += f1 * bf_hi(y.y); }
        if (nsel > 2) { const v2u x = *(const v2u*)(pp + 2 * PLANE + 8 * g), y = *(const v2u*)(pp + 2 * PLANE + 32 + 8 * g);
            a[0] += f2 * bf_lo(x.x); a[1] += f2 * bf_hi(x.x); a[2] += f2 * bf_lo(x.y); a[3] += f2 * bf_hi(x.y); a[4] += f2 * bf_lo(y.x); a[5] += f2 * bf_hi(y.x); a[6] += f2 * bf_lo(y.y); a[7] += f2 * bf_hi(y.y); }
        v2u wa, wb; wa.x = pk2(a[0], a[1]); wa.y = pk2(a[2], a[3]); wb.x = pk2(a[4], a[5]); wb.y = pk2(a[6], a[7]);
        *(v2u*)(dst + 8 * g) = wa; *(v2u*)(dst + 32 + 8 * g) = wb; }
}
__device__ __forceinline__ void p5_own(Frame& F, const Args& A) {
    using namespace att;
    const bf16* Qt = (const bf16*)(F.ws + WS_PROJ); const bf16* Kt = Qt + (size_t)1 * NTOK * 512; const bf16* Vt = Qt + (size_t)2 * NTOK * 512;
    const bf16* PO = (const bf16*)F.out; const float* PL = (const float*)((const unsigned char*)F.out + 3 * PLANE * 2);
    bf16* AO = (bf16*)(F.ws + WS_AO);
    LAS unsigned char* lds = F.lds + RING_OFF;
    const LAS float* btab = (const LAS float*)(F.lds + BTAB_OFF);
    const int lane = F.lane, r32 = lane & 31, hi = lane >> 5, w = F.wave;
    const int swz = (r32 >> 1) & 7; int kb[4];
#pragma unroll
    for (int d0 = 0; d0 < 4; ++d0) kb[d0] = r32 * 128 + (((2 * d0 + hi) ^ swz) << 4);
    const int q_ = (lane & 15) >> 2, p_ = lane & 3, g1 = (lane >> 4) & 1;
    const int vb0 = (4 * hi + q_) * 128 + ((0 ^ (q_ >> 1)) << 6) + (16 * g1 + 4 * p_) * 2, vb1 = (4 * hi + q_) * 128 + ((1 ^ (q_ >> 1)) << 6) + (16 * g1 + 4 * p_) * 2;
    int hprev = -1;
    for (int pidx = blockIdx.x; pidx < 16 * (NBLK / 2); pidx += F.G) {
        const int bh = pidx & 15, qa = pidx >> 4, qb = NBLK - 1 - qa, b = bh >> 3, h = bh & 7;
        __syncthreads();
        if (h != hprev) { build_btab8(F, A, h); hprev = h; }
        load_kv(lds, Kt, Vt, b, h, qa, F.tid, F.wave);
        load_kv(lds + 65536, Kt, Vt, b, h, qb, F.tid, F.wave);
        asm volatile("s_waitcnt vmcnt(0)" ::: "memory");
        __syncthreads();
        own_tile(lds, btab, bh, qa, w, Qt, PO, PL, AO, kb, vb0, vb1, r32, hi);
        own_tile(lds + 65536, btab, bh, qb, 7 - w, Qt, PO, PL, AO, kb, vb0, vb1, r32, hi);
    }
    __syncthreads();
}
__global__ void __launch_bounds__(NWAVES * 64, 2) mk_fwd(Args args) {
    extern __shared__ __attribute__((aligned(16))) unsigned char lds[];
    Frame F;
    F.lds = (LAS unsigned char*)lds;
    F.MISC = (volatile LAS unsigned*)(F.lds + MISC_OFF);
    F.tid = threadIdx.x; F.lane = F.tid & 63; F.wave = __builtin_amdgcn_readfirstlane(F.tid >> 6);
    F.G = gridDim.x; { const int bx = blockIdx.x; F.vcu = (F.G % 8 == 0) ? (bx % 8) * (F.G / 8) + bx / 8 : bx; }
    F.ws = args.ws; F.ctl = (gu32*)(args.ws + WS_CTL); F.out = args.out;
    for (int u = F.tid; u < (LDS_BYTES - LDSCTL_OFF) / 4; u += NWAVES * 64) ((LAS unsigned*)(F.lds + LDSCTL_OFF))[u] = 0u;
    __syncthreads();
    XcdBarrier bar; bar.bar = (unsigned*)(F.ctl + CW_BAR); bar.x = 0; bar.st = nullptr;
    if (N_LAUNCHES != PER_PHASE) bar = xcd_barrier_post((unsigned*)(F.ctl + CW_BAR), F.MISC + 8);
#define GRID_BAR(seam) do { if (N_LAUNCHES == PER_PHASE) { if (F.tid == 0) __hip_atomic_store(F.ctl + CW_TMO, 0xBADBA0u | (unsigned)(seam), RLX_AGENT); } else { xcd_barrier(bar); } } while (0)
    const int lo = args.ph_lo, hi = args.ph_hi;
#define IN(k) (lo <= (k) && (k) < hi)
#define PHM(k) ((PH_MASK >> (k)) & 1)
#define BOTH(k) (IN(k) && IN((k) + 1))
    bf16* PROJ = (bf16*)(F.ws + WS_PROJ);

    if (PHM(0) && IN(0)) { p0_prologue(F, args); if (PROBE_PHASE == 0) { GRID_BAR(0); p0_prologue(F, args); } if (BOTH(0)) GRID_BAR(0); }
    if (PHM(1) && IN(1)) { p1_hrows(F, args); if (PROBE_PHASE == 1) { GRID_BAR(1); p1_hrows(F, args); } if (BOTH(1)) GRID_BAR(1); }
    if (PHM(2) && IN(2)) {
        {
        pg8::Gemm g{(const bf16*)(F.ws + WS_H), (const bf16*)(F.ws + WS_WIN), NTOK, INW, D, 0};
        pg8::StaticOrder S; S.init(NTOK, INW, F.G, (int)blockIdx.x);
        pg8::EpiProj E{PROJ, args.in[6], (float*)(F.ws + WS_KSUM)};
        pg8::gemm_phase<pg8::EpiProj, pg8::StaticOrder, true, true>(F.lds + RING_OFF, g, S, E);
        }
        if (PROBE_PHASE == 2) { GRID_BAR(2);
        pg8::Gemm g{(const bf16*)(F.ws + WS_H), (const bf16*)(F.ws + WS_WIN), NTOK, INW, D, 0};
        pg8::StaticOrder S; S.init(NTOK, INW, F.G, (int)blockIdx.x);
        pg8::EpiProj E{PROJ, args.in[6], (float*)(F.ws + WS_KSUM)};
        pg8::gemm_phase<pg8::EpiProj, pg8::StaticOrder, true, true>(F.lds + RING_OFF, g, S, E);
        }
        if (BOTH(2)) GRID_BAR(2);
    }
    if (PHM(3) && IN(3)) { p3_pooldiff(F, args); p3_route(F); if (PROBE_PHASE == 3) { GRID_BAR(3); p3_pooldiff(F, args); p3_route(F); } if (BOTH(3)) GRID_BAR(3); }
#if defined(ATTN_NAIVE)
    if (PHM(4) && IN(4)) { p4_attn_naive(F, args); if (PROBE_PHASE == 4) { GRID_BAR(4); p4_attn_naive(F, args); } if (BOTH(4)) GRID_BAR(4); }
#else
    if (PHM(4) && IN(4)) { p4_selected(F, args); if (PROBE_PHASE == 4) { GRID_BAR(4); p4_selected(F, args); } if (BOTH(4)) GRID_BAR(4); }
    if (PHM(5) && IN(5)) { p5_own(F, args); if (PROBE_PHASE == 5) { GRID_BAR(5); p5_own(F, args); } if (BOTH(5)) GRID_BAR(5); }
#endif
    if (PHM(6) && IN(6)) {
        {
        bf16* T = (bf16*)(F.ws + WS_T);
        { pg8::Gemm g{(const bf16*)(F.ws + WS_AO), (const bf16*)(F.ws + WS_WBA), NTOK, D, AW, 0};
          pg8::StaticOrder S; S.init(NTOK, D, F.G, (int)blockIdx.x);
          pg8::EpiGate<false> E{PROJ + (size_t)4 * NTOK * 512, T};
          pg8::gemm_phase<pg8::EpiGate<false>, pg8::StaticOrder, false, true>(F.lds + RING_OFF, g, S, E); }
        VM_WAIT(); __syncthreads();
        { pg8::Gemm g{(const bf16*)(F.ws + WS_DP), (const bf16*)(F.ws + WS_WCOMB), NTOK, D, PW, 0};
          pg8::StaticOrder S; S.init(NTOK, D, F.G, (int)blockIdx.x);
          pg8::EpiGate<true> E{PROJ + (size_t)6 * NTOK * 512, T};
          pg8::gemm_phase<pg8::EpiGate<true>, pg8::StaticOrder, false, true>(F.lds + RING_OFF, g, S, E); }
        }
        if (PROBE_PHASE == 6) { GRID_BAR(6);
        bf16* T = (bf16*)(F.ws + WS_T);
        { pg8::Gemm g{(const bf16*)(F.ws + WS_AO), (const bf16*)(F.ws + WS_WBA), NTOK, D, AW, 0};
          pg8::StaticOrder S; S.init(NTOK, D, F.G, (int)blockIdx.x);
          pg8::EpiGate<false> E{PROJ + (size_t)4 * NTOK * 512, T};
          pg8::gemm_phase<pg8::EpiGate<false>, pg8::StaticOrder, false, true>(F.lds + RING_OFF, g, S, E); }
        VM_WAIT(); __syncthreads();
        { pg8::Gemm g{(const bf16*)(F.ws + WS_DP), (const bf16*)(F.ws + WS_WCOMB), NTOK, D, PW, 0};
          pg8::StaticOrder S; S.init(NTOK, D, F.G, (int)blockIdx.x);
          pg8::EpiGate<true> E{PROJ + (size_t)6 * NTOK * 512, T};
          pg8::gemm_phase<pg8::EpiGate<true>, pg8::StaticOrder, false, true>(F.lds + RING_OFF, g, S, E); }
        }
        if (BOTH(6)) GRID_BAR(6);
    }
    if (PHM(7) && IN(7)) {
        {
        pg8::Gemm g{(const bf16*)(F.ws + WS_T), (const bf16*)(F.ws + WS_WOUT), NTOK, D, D, 0};
        pg8::StaticOrder S; S.init(NTOK, D, F.G, (int)blockIdx.x);
        pg8::EpiRes E{args.in[0], F.out, (const float*)(F.ws + WS_MOD)};
        pg8::gemm_phase<pg8::EpiRes, pg8::StaticOrder, false, true>(F.lds + RING_OFF, g, S, E);
        }
        if (PROBE_PHASE == 7) { GRID_BAR(7);
        pg8::Gemm g{(const bf16*)(F.ws + WS_T), (const bf16*)(F.ws + WS_WOUT), NTOK, D, D, 0};
        pg8::StaticOrder S; S.init(NTOK, D, F.G, (int)blockIdx.x);
        pg8::EpiRes E{args.in[0], F.out, (const float*)(F.ws + WS_MOD)};
        pg8::gemm_phase<pg8::EpiRes, pg8::StaticOrder, false, true>(F.lds + RING_OFF, g, S, E);
        }
        if (BOTH(7)) GRID_BAR(7);
    }
    if (PHM(8) && IN(8)) { p8_norm_route(F, args); if (PROBE_PHASE == 8) { GRID_BAR(8); if (F.tid < NE && blockIdx.x == 0) __hip_atomic_store((unsigned*)(F.ctl + CW_ECNT + 64 * F.tid), 0u, RLX_AGENT); GRID_BAR(8); p8_norm_route(F, args); } if (BOTH(8)) GRID_BAR(8); }
    if (PHM(9) && IN(9)) { p8_gather(F, args); if (PROBE_PHASE == 9) { GRID_BAR(9); p8_gather(F, args); } if (BOTH(9)) GRID_BAR(9); }
    if (PHM(10) && IN(10)) {
        {
        build_tables(F);
        const int ntiles = ((const LAS int*)(F.lds + TOFF_OFF))[NE];
        pg8::Gemm g{(const bf16*)(F.ws + WS_XG), (const bf16*)(F.ws + WS_WGU), ntiles * 256, D, D, (size_t)D * D * 2};
        pg8::GroupedOrder S; S.so.init(ntiles * 256, D, F.G, (int)blockIdx.x); S.tile_e = (const LAS int*)(F.lds + TILEE_OFF);
        pg8::EpiSwiglu E{(bf16*)(F.ws + WS_ACT)};
        pg8::gemm_phase<pg8::EpiSwiglu, pg8::GroupedOrder, true, true>(F.lds + RING_OFF, g, S, E);
        }
        if (PROBE_PHASE == 10) { GRID_BAR(10);
        build_tables(F);
        const int ntiles = ((const LAS int*)(F.lds + TOFF_OFF))[NE];
        pg8::Gemm g{(const bf16*)(F.ws + WS_XG), (const bf16*)(F.ws + WS_WGU), ntiles * 256, D, D, (size_t)D * D * 2};
        pg8::GroupedOrder S; S.so.init(ntiles * 256, D, F.G, (int)blockIdx.x); S.tile_e = (const LAS int*)(F.lds + TILEE_OFF);
        pg8::EpiSwiglu E{(bf16*)(F.ws + WS_ACT)};
        pg8::gemm_phase<pg8::EpiSwiglu, pg8::GroupedOrder, true, true>(F.lds + RING_OFF, g, S, E);
        }
        if (BOTH(10)) GRID_BAR(10);
    }
    if (PHM(11) && IN(11)) {
        {
        build_tables(F);
        const int ntiles = ((const LAS int*)(F.lds + TOFF_OFF))[NE];
        pg8::Gemm g{(const bf16*)(F.ws + WS_ACT), (const bf16*)(F.ws + WS_WD), ntiles * 256, D, DE, (size_t)D * DE * 2};
        pg8::GroupedOrder S; S.so.init(ntiles * 256, D, F.G, (int)blockIdx.x); S.tile_e = (const LAS int*)(F.lds + TILEE_OFF);
        pg8::EpiY E{(bf16*)(F.ws + WS_Y)};
        pg8::gemm_phase<pg8::EpiY, pg8::GroupedOrder, true, true>(F.lds + RING_OFF, g, S, E);
        }
        if (PROBE_PHASE == 11) { GRID_BAR(11);
        build_tables(F);
        const int ntiles = ((const LAS int*)(F.lds + TOFF_OFF))[NE];
        pg8::Gemm g{(const bf16*)(F.ws + WS_ACT), (const bf16*)(F.ws + WS_WD), ntiles * 256, D, DE, (size_t)D * DE * 2};
        pg8::GroupedOrder S; S.so.init(ntiles * 256, D, F.G, (int)blockIdx.x); S.tile_e = (const LAS int*)(F.lds + TILEE_OFF);
        pg8::EpiY E{(bf16*)(F.ws + WS_Y)};
        pg8::gemm_phase<pg8::EpiY, pg8::GroupedOrder, true, true>(F.lds + RING_OFF, g, S, E);
        }
        if (BOTH(11)) GRID_BAR(11);
    }
    if (PHM(12) && IN(12)) { p11_final(F, args); }
#undef IN
#undef BOTH
}

extern "C" void kernel_launch(void* const* d_in, const int* in_sizes, int n_in, void* d_out, int out_size, void* d_ws, size_t ws_size, hipStream_t stream) {
    static int grid = 0;
    if (grid == 0) {
        if (n_in != 22 || in_sizes[0] != NTOK * D || out_size != NTOK * D || ws_size < WS_END) { fprintf(stderr, "kernel_launch: unexpected shapes (n_in %d, in0 %d, out %d, ws %zu); nothing launched\n", n_in, n_in > 0 ? in_sizes[0] : -1, out_size, ws_size); grid = -1; return; }
        int dev = 0, cus = 0, per_cu = 0;
        if (hipGetDevice(&dev) != hipSuccess || hipDeviceGetAttribute(&cus, hipDeviceAttributeMultiprocessorCount, dev) != hipSuccess) { fprintf(stderr, "kernel_launch: device query failed\n"); grid = -1; return; }
        if (hipFuncSetAttribute((const void*)mk_fwd, hipFuncAttributeMaxDynamicSharedMemorySize, LDS_BYTES) != hipSuccess) { fprintf(stderr, "kernel_launch: hipFuncSetAttribute failed\n"); grid = -1; return; }
        if (hipOccupancyMaxActiveBlocksPerMultiprocessor(&per_cu, (const void*)mk_fwd, NWAVES * 64, LDS_BYTES) != hipSuccess || per_cu < 1)
            fprintf(stderr, "kernel_launch: note: occupancy query reports %d workgroups per CU\n", per_cu);
        (void)hipGetLastError();
        grid = cus;
    }
    if (grid < 0) return;
    if (hipMemsetAsync((char*)d_ws + WS_CTL, 0, CTL_ZERO_BYTES, stream) != hipSuccess) { fprintf(stderr, "kernel_launch: memset failed\n"); return; }
    Args a{};
    for (int i = 0; i < 22; ++i) a.in[i] = (const float*)d_in[i];
    a.out = (float*)d_out; a.ws = (unsigned char*)d_ws;
    if (N_LAUNCHES == 1) { a.ph_lo = 0; a.ph_hi = PER_PHASE; hipLaunchKernelGGL(mk_fwd, dim3(grid), dim3(NWAVES * 64), LDS_BYTES, stream, a); }
    else for (int li = 0; li < PER_PHASE; ++li) { a.ph_lo = li; a.ph_hi = li + 1; hipLaunchKernelGGL(mk_fwd, dim3(grid), dim3(NWAVES * 64), LDS_BYTES, stream, a); }
}
```

```cpp
#include <hip/hip_runtime.h>
#include <cstdio>
#include <cstdint>

constexpr int BATCH = 2, SEQ = 8192, D = 1024, NTOK = BATCH * SEQ;
constexpr int NH = 8, HD = 64, AW = 512, MBLK = 256, NBLK = SEQ / MBLK;
constexpr int PW = 512, PGW = 128;
constexpr int INW = 4096;
constexpr int NE = 32, DE = 512;
constexpr int NMOD = 6;
constexpr int MAXTILES = 160;
constexpr float EPS = 1e-6f;
constexpr float NEG_INF = -1e30f;

namespace pg8 {
#define PG8_LAS __attribute__((address_space(3)))
typedef unsigned short bf16_t;
typedef short bf16x8 __attribute__((ext_vector_type(8)));
typedef float f32x4 __attribute__((ext_vector_type(4)));
typedef unsigned u32x4 __attribute__((ext_vector_type(4)));
typedef unsigned u32x2 __attribute__((ext_vector_type(2)));
constexpr int BM = 256, BK = 64, HALF = 128, HTB = HALF * BK * 2  , STAGE_BYTES = 8 * HTB, NXCD = 8, WGM = 8;

__host__ __device__ __forceinline__ int lds_byte(int r, int c) { const int st = (r >> 4) * 2 + (c >> 5), rr = r & 15, cc = c & 31, ob = rr * 64 + cc * 2; return st * 1024 + (ob ^ (((ob >> 9) & 1) << 5)); }
__host__ __device__ __forceinline__ void stage_rc(int b, int& R, int& C) { const int st = b / 1024, sb = b % 1024, swz = sb ^ (((sb >> 9) & 1) << 5); R = (st >> 1) * 16 + swz / 64; C = (st & 1) * 32 + (swz % 64) / 2; }
__host__ __device__ __forceinline__ int perm32(int rho) { const int n = rho >> 4, i = rho & 15; return 8 * (i >> 2) + 4 * n + (i & 3); }

struct Unit { int pm, pn, e, p0, cnt; };
struct Gemm { const bf16_t* A; const bf16_t* Bt; int M, N, K; size_t estride; const int* glist; int gstride; };

struct StaticOrder {
    int nM, nN, nwg, G, c;
    __host__ __device__ void init(int M, int N, int G_, int c_) { nM = M / BM; nN = N / BM; nwg = nM * nN; G = G_; c = c_; }
    __host__ __device__ bool next(int i, Unit& u) const {
        const long L = (long)i * G + c; if (L >= nwg) return false;
        int wgid = (int)L; { const int q = nwg / NXCD, r = nwg % NXCD, xcd = wgid % NXCD, off = wgid / NXCD; wgid = (xcd < r ? xcd * (q + 1) : r * (q + 1) + (xcd - r) * q) + off; }
        const int nig = WGM * nN, gid = wgid / nig, fm = gid * WGM, gsz = (nM - fm) < WGM ? (nM - fm) : WGM;
        u.pm = fm + ((wgid % nig) % gsz); u.pn = (wgid % nig) / gsz; u.e = 0; u.p0 = 0; u.cnt = 0; return true;
    }
    __device__ __forceinline__ void a_ready(const Unit&) const {}
    __device__ __forceinline__ void done(const Unit&) const {}
};
struct GroupedOrder {
    StaticOrder so; const PG8_LAS int* tile_e; const PG8_LAS int* toff; const PG8_LAS int* ecnt;
    __device__ __forceinline__ bool next(int i, Unit& u) const {
        if (!so.next(i, u)) return false;
        u.e = __builtin_amdgcn_readfirstlane(tile_e[u.pm]); u.p0 = (u.pm - __builtin_amdgcn_readfirstlane(toff[u.e])) * 256; u.cnt = __builtin_amdgcn_readfirstlane(ecnt[u.e]); return true;
    }
    __device__ __forceinline__ void a_ready(const Unit&) const {}
    __device__ __forceinline__ void done(const Unit&) const {}
};

__device__ __forceinline__ unsigned cvt_pk_bf16(float lo, float hi) { unsigned r; asm volatile("v_cvt_pk_bf16_f32 %0, %1, %2" : "=v"(r) : "v"(lo), "v"(hi)); return r; }
__device__ __forceinline__ float bf_lo(unsigned u) { return __uint_as_float(u << 16); }
__device__ __forceinline__ float bf_hi(unsigned u) { return __uint_as_float(u & 0xffff0000u); }
__device__ __forceinline__ float sigm(float x) { return 1.0f / (1.0f + __expf(-x)); }
__device__ __forceinline__ u32x4 pack8(const f32x4 v0, const f32x4 v1) { u32x4 w; w.x = cvt_pk_bf16(v0[0], v0[1]); w.y = cvt_pk_bf16(v0[2], v0[3]); w.z = cvt_pk_bf16(v1[0], v1[1]); w.w = cvt_pk_bf16(v1[2], v1[3]); return w; }

struct EpiProj {
    static constexpr bool PERM = true, AFTER_DRAIN = false;
    bf16_t* O; const float* bgate; float* ksum;
    __device__ __forceinline__ void operator()(const f32x4 (&acc)[2][2][4][2], const Unit& u, int wr, int wc, int fr, int fq) const {
        const int t = u.pn >> 1, colt = (u.pn & 1) * 256; const bool gate = t >= 4;
        if (t == 1) {
#pragma unroll
            for (int bj = 0; bj < 2; ++bj)
#pragma unroll
                for (int n = 0; n < 2; ++n) { f32x4 s = (f32x4){0.f, 0.f, 0.f, 0.f};
#pragma unroll
                    for (int ai = 0; ai < 2; ++ai)
#pragma unroll
                        for (int m = 0; m < 4; ++m) s += acc[ai][bj][m][n];
#pragma unroll
                    for (int j = 0; j < 4; ++j) { float v = s[j]; v += __shfl_xor(v, 1); v += __shfl_xor(v, 2); v += __shfl_xor(v, 4); v += __shfl_xor(v, 8); s[j] = v; }
                    if (fr == 0) { const int c = colt + bj * HALF + wc * 32 + 8 * fq + 4 * n;
                        float* kp = ksum + (size_t)(((u.pm >> 5) * NH + (c >> 6)) * NBLK + (u.pm & 31)) * HD + (c & 63);
#pragma unroll
                        for (int j = 0; j < 4; ++j) atomicAdd(kp + j, s[j]); } }
        }
        bf16_t* base = O + (size_t)t * ((size_t)NTOK * 512);
        const int row0 = u.pm * BM + wr * 64 + fr, col0 = colt + wc * 32 + 8 * fq, bcol0 = u.pn * BM - 2048 + wc * 32 + 8 * fq;
        f32x4 bv[2][2];
#pragma unroll
        for (int bj = 0; bj < 2; ++bj)
#pragma unroll
            for (int n = 0; n < 2; ++n) bv[bj][n] = gate ? *(const f32x4*)(bgate + bcol0 + bj * HALF + 4 * n) : (f32x4){0.f, 0.f, 0.f, 0.f};
#pragma unroll
        for (int ai = 0; ai < 2; ++ai)
#pragma unroll
            for (int m = 0; m < 4; ++m) { bf16_t* rowp = base + (size_t)(row0 + ai * HALF + m * 16) * 512 + col0;
#pragma unroll
                for (int bj = 0; bj < 2; ++bj) { f32x4 v0 = acc[ai][bj][m][0] + bv[bj][0], v1 = acc[ai][bj][m][1] + bv[bj][1];
                    if (gate) {
#pragma unroll
                        for (int j = 0; j < 4; ++j) { v0[j] = sigm(v0[j]); v1[j] = sigm(v1[j]); } }
                    *(u32x4*)(rowp + bj * HALF) = pack8(v0, v1); } }
    }
};
template <bool SECOND> struct EpiGate {
    static constexpr bool PERM = true, AFTER_DRAIN = false;
    const bf16_t* G; bf16_t* T;
    __device__ __forceinline__ void operator()(const f32x4 (&acc)[2][2][4][2], const Unit& u, int wr, int wc, int fr, int fq) const {
        const bf16_t* gbase = G + (size_t)(u.pn >> 1) * ((size_t)NTOK * 512);
        const int row0 = u.pm * BM + wr * 64 + fr, gcol0 = (u.pn & 1) * 256 + wc * 32 + 8 * fq, col0 = u.pn * BM + wc * 32 + 8 * fq;
#pragma unroll
        for (int ai = 0; ai < 2; ++ai)
#pragma unroll
            for (int m = 0; m < 4; ++m) { const int r = row0 + ai * HALF + m * 16;
#pragma unroll
                for (int bj = 0; bj < 2; ++bj) {
                    const u32x4 gv = *(const u32x4*)(gbase + (size_t)r * 512 + gcol0 + bj * HALF);
                    bf16_t* tp = T + (size_t)r * 1024 + col0 + bj * HALF;
                    f32x4 v0 = acc[ai][bj][m][0] * (f32x4){bf_lo(gv.x), bf_hi(gv.x), bf_lo(gv.y), bf_hi(gv.y)};
                    f32x4 v1 = acc[ai][bj][m][1] * (f32x4){bf_lo(gv.z), bf_hi(gv.z), bf_lo(gv.w), bf_hi(gv.w)};
                    if (SECOND) { const u32x4 tv = *(const u32x4*)tp;
                        v0 += (f32x4){bf_lo(tv.x), bf_hi(tv.x), bf_lo(tv.y), bf_hi(tv.y)}; v1 += (f32x4){bf_lo(tv.z), bf_hi(tv.z), bf_lo(tv.w), bf_hi(tv.w)}; }
                    *(u32x4*)tp = pack8(v0, v1); } }
    }
};
struct EpiRes {
    static constexpr bool PERM = true, AFTER_DRAIN = false;
    const float* x; bf16_t* out; const float* mod;
    __device__ __forceinline__ void operator()(const f32x4 (&acc)[2][2][4][2], const Unit& u, int wr, int wc, int fr, int fq) const {
        const int b = (u.pm * BM) / SEQ; const float* gp = mod + b * (NMOD * D) + 2 * D;
        const int row0 = u.pm * BM + wr * 64 + fr, col0 = u.pn * BM + wc * 32 + 8 * fq;
        f32x4 gv[2][2];
#pragma unroll
        for (int bj = 0; bj < 2; ++bj)
#pragma unroll
            for (int n = 0; n < 2; ++n) gv[bj][n] = *(const f32x4*)(gp + col0 + bj * HALF + 4 * n);
#pragma unroll
        for (int ai = 0; ai < 2; ++ai)
#pragma unroll
            for (int m = 0; m < 4; ++m) { const size_t off = (size_t)(row0 + ai * HALF + m * 16) * D + col0;
#pragma unroll
                for (int bj = 0; bj < 2; ++bj) { const f32x4 x0 = *(const f32x4*)(x + off + bj * HALF), x1 = *(const f32x4*)(x + off + bj * HALF + 4);
                    *(u32x4*)(out + off + bj * HALF) = pack8(x0 + gv[bj][0] * acc[ai][bj][m][0], x1 + gv[bj][1] * acc[ai][bj][m][1]); } }
    }
};
struct EpiSwiglu {
    static constexpr bool PERM = false, AFTER_DRAIN = false;
    bf16_t* act;
    __device__ __forceinline__ void operator()(const f32x4 (&acc)[2][2][4][2], const Unit& u, int wr, int wc, int fr, int fq) const {
        const int row0 = u.pm * BM + wr * 64 + fr, col0 = u.pn * 128 + wc * 16 + 4 * fq;
#pragma unroll
        for (int ai = 0; ai < 2; ++ai)
#pragma unroll
            for (int m = 0; m < 4; ++m) { bf16_t* rowp = act + (size_t)(row0 + ai * HALF + m * 16) * DE + col0;
#pragma unroll
                for (int bj = 0; bj < 2; ++bj) { const f32x4 g = acc[ai][bj][m][0], up = acc[ai][bj][m][1]; f32x4 a;
#pragma unroll
                    for (int j = 0; j < 4; ++j) a[j] = g[j] * sigm(g[j]) * up[j];
                    u32x2 w; w.x = cvt_pk_bf16(a[0], a[1]); w.y = cvt_pk_bf16(a[2], a[3]);
                    *(u32x2*)(rowp + bj * 64) = w; } }
    }
};
struct EpiY {
    static constexpr bool PERM = true, AFTER_DRAIN = false;
    bf16_t* Y;
    __device__ __forceinline__ void operator()(const f32x4 (&acc)[2][2][4][2], const Unit& u, int wr, int wc, int fr, int fq) const {
        const int row0 = u.pm * BM + wr * 64 + fr, col0 = u.pn * BM + wc * 32 + 8 * fq;
#pragma unroll
        for (int ai = 0; ai < 2; ++ai)
#pragma unroll
            for (int m = 0; m < 4; ++m) { bf16_t* rowp = Y + (size_t)(row0 + ai * HALF + m * 16) * D + col0;
#pragma unroll
                for (int bj = 0; bj < 2; ++bj) *(u32x4*)(rowp + bj * HALF) = pack8(acc[ai][bj][m][0], acc[ai][bj][m][1]); }
    }
};

template <class Epi, class Sched, bool ALIGN_EPI = false, bool SP2 = false, bool GATHER = false>
__device__ __forceinline__ void gemm_phase(PG8_LAS unsigned char* lds, const Gemm g, const Sched& S, const Epi& E) {
    const int tid = threadIdx.x, wid = __builtin_amdgcn_readfirstlane(tid >> 6), lane = tid & 63, wr = wid >> 2, wc = wid & 3, fr = lane & 15, fq = lane >> 4;
    const int K = g.K, nt = K / BK;
    unsigned voffA[2], voffB[2]; int gR[2]; unsigned gC[2];
    static_assert(!GATHER || SP2, "gathered A operand: SP2 loop only");
#pragma unroll
    for (int i = 0; i < 2; ++i) { int R, C; stage_rc(tid * 16 + i * 8192, R, C); const int Rb = Epi::PERM ? ((R & ~31) + perm32(R & 31)) : R;
        voffA[i] = (unsigned)(R * K + C) * 2u; voffB[i] = (unsigned)(Rb * K + C) * 2u; gR[i] = R; gC[i] = (unsigned)C * 2u; }
    const size_t kstep = (size_t)(BK * 2);
    const size_t hstep = (size_t)HALF * K * 2;
    const size_t tstep = 2 * hstep;
    const unsigned ldsw = (unsigned)wid * 1024u;
    const int aoff = lds_byte(wr * 64 + fr, fq * 8), boff = lds_byte(wc * 32 + fr, fq * 8);
#define PG8_SA(b, h) (((b) * 2 + (h)) * HTB)
#define PG8_SB(b, h) ((4 + (b) * 2 + (h)) * HTB)
#define PG8_STAGE(bufoff, gbase, voff) do { _Pragma("unroll") for (int _i = 0; _i < 2; ++_i) \
        __builtin_amdgcn_global_load_lds((const unsigned*)((const char*)(gbase) + (voff)[_i]), (PG8_LAS unsigned*)(lds + (bufoff) + ldsw + _i * 8192), 16, 0, 0); } while (0)
#define PG8_STAGE_A(bufoff, gbase, h, VO) do { if constexpr (GATHER) { PG8_STAGE(bufoff, gbase, VO[h]); } else { PG8_STAGE(bufoff, (gbase) + (h) * hstep, voffA); } } while (0)
#define PG8_GOFF(dst, u) do { _Pragma("unroll") for (int _h = 0; _h < 2; ++_h) _Pragma("unroll") for (int _i = 0; _i < 2; ++_i) { const int _pos = (u).p0 + 128 * _h + gR[_i]; \
        const int _tok = _pos < (u).cnt ? g.glist[(size_t)(u).e * g.gstride + _pos] : 0; dst[_h][_i] = (unsigned)_tok * (unsigned)(K * 2) + gC[_i]; } } while (0)
#define PG8_LDA(dst, b, h) do { _Pragma("unroll") for (int m = 0; m < 4; ++m) _Pragma("unroll") for (int k = 0; k < 2; ++k) dst[m][k] = *(const PG8_LAS bf16x8*)(lds + PG8_SA(b, h) + aoff + m * 2048 + k * 1024); } while (0)
#define PG8_LDB(dst, b, h) do { _Pragma("unroll") for (int n = 0; n < 2; ++n) _Pragma("unroll") for (int k = 0; k < 2; ++k) dst[n][k] = *(const PG8_LAS bf16x8*)(lds + PG8_SB(b, h) + boff + n * 2048 + k * 1024); } while (0)
#define PG8_MMA(ai, bj, At, Bt) do { __builtin_amdgcn_s_setprio(1); _Pragma("unroll") for (int m = 0; m < 4; ++m) _Pragma("unroll") for (int n = 0; n < 2; ++n) _Pragma("unroll") for (int k = 0; k < 2; ++k) \
        acc[ai][bj][m][n] = __builtin_amdgcn_mfma_f32_16x16x32_bf16(Bt[n][k], At[m][k], acc[ai][bj][m][n], 0, 0, 0); __builtin_amdgcn_s_setprio(0); } while (0)
#define PG8_WAIT_V(n) asm volatile("s_waitcnt vmcnt(" #n ")" ::: "memory")
#define PG8_WAIT_L(n) asm volatile("s_waitcnt lgkmcnt(" #n ")" ::: "memory")
#define PG8_BAR __builtin_amdgcn_s_barrier()
#define PG8_SCHED __builtin_amdgcn_sched_barrier(0)
    Unit cur, nxt; int ui = 0;
    if (!S.next(0, cur)) return;
    f32x4 acc[2][2][4][2];
#pragma unroll
    for (int a = 0; a < 2; ++a)
#pragma unroll
        for (int b = 0; b < 2; ++b)
#pragma unroll
            for (int m = 0; m < 4; ++m)
#pragma unroll
                for (int n = 0; n < 2; ++n) acc[a][b][m][n] = (f32x4){0.f, 0.f, 0.f, 0.f};
    bf16x8 At[4][2], B0[2][2], B1[2][2];
    const char* cA = (const char*)g.A + (GATHER ? (size_t)0 : (size_t)cur.pm * tstep); const char* cB = (const char*)g.Bt + (size_t)cur.e * g.estride + (size_t)cur.pn * tstep;
    unsigned gvo[2][2] = {{0u, 0u}, {0u, 0u}}, ngvo[2][2] = {{0u, 0u}, {0u, 0u}}, sel[2][2] = {{0u, 0u}, {0u, 0u}};
    if constexpr (GATHER) PG8_GOFF(gvo, cur);
    S.a_ready(cur);
    if constexpr (SP2) {
        PG8_STAGE(PG8_SB(0, 0), cB, voffB); PG8_STAGE(PG8_SB(0, 1), cB + hstep, voffB); PG8_STAGE_A(PG8_SA(0, 0), cA, 0, gvo); PG8_STAGE_A(PG8_SA(0, 1), cA, 1, gvo);
        if (wr == 1) PG8_BAR;
        PG8_WAIT_V(2); PG8_BAR;
        PG8_STAGE(PG8_SB(1, 0), cB + kstep, voffB); PG8_STAGE_A(PG8_SA(1, 0), cA + kstep, 0, gvo); PG8_STAGE(PG8_SB(1, 1), cB + hstep + kstep, voffB);
        PG8_WAIT_V(6); PG8_BAR;
    } else {
        PG8_STAGE(PG8_SB(0, 0), cB, voffB); PG8_STAGE(PG8_SA(0, 0), cA, voffA); PG8_STAGE(PG8_SB(0, 1), cB + hstep, voffB); PG8_STAGE(PG8_SA(0, 1), cA + hstep, voffA);
        if (wr == 1) PG8_BAR;
        PG8_WAIT_V(4); PG8_BAR;
        PG8_STAGE(PG8_SB(1, 0), cB + kstep, voffB); PG8_STAGE(PG8_SA(1, 0), cA + kstep, voffA); PG8_STAGE(PG8_SB(1, 1), cB + hstep + kstep, voffB);
        PG8_WAIT_V(6); PG8_BAR;
    }
    for (;;) {
        const bool has_next = S.next(ui + 1, nxt);
        if constexpr (GATHER) { if (has_next) { PG8_GOFF(ngvo, nxt); } else { _Pragma("unroll") for (int _h = 0; _h < 2; ++_h) _Pragma("unroll") for (int _i = 0; _i < 2; ++_i) ngvo[_h][_i] = gvo[_h][_i]; } }
        const char* nA = (has_next && !GATHER) ? (const char*)g.A + (size_t)nxt.pm * tstep : cA; const char* nB = has_next ? (const char*)g.Bt + (size_t)nxt.e * g.estride + (size_t)nxt.pn * tstep : cB;
        for (int t = 0; t < nt; t += 2) {
            const bool last = (t == nt - 2);
            const char* a1 = cA + (size_t)(t + 1) * kstep;
            const char* a2 = last ? nA : cA + (size_t)(t + 2) * kstep; const char* b2 = last ? nB : cB + (size_t)(t + 2) * kstep;
            const char* a3 = a2 + kstep; const char* b3 = b2 + kstep;
            if (last && has_next) S.a_ready(nxt);
            if constexpr (GATHER) { _Pragma("unroll") for (int _h = 0; _h < 2; ++_h) _Pragma("unroll") for (int _i = 0; _i < 2; ++_i) sel[_h][_i] = last ? ngvo[_h][_i] : gvo[_h][_i]; }
            if constexpr (SP2) {
            PG8_LDB(B0, 0, 0); PG8_LDB(B1, 0, 1); PG8_SCHED; PG8_LDA(At, 0, 0); PG8_STAGE_A(PG8_SA(1, 1), a1, 1, gvo);
            PG8_WAIT_V(8); PG8_WAIT_L(0); PG8_BAR; PG8_MMA(0, 0, At, B0); PG8_MMA(0, 1, At, B1); PG8_BAR; PG8_SCHED;
            PG8_LDA(At, 0, 1); PG8_STAGE(PG8_SB(0, 0), b2, voffB); PG8_STAGE(PG8_SB(0, 1), b2 + hstep, voffB); PG8_STAGE_A(PG8_SA(0, 0), a2, 0, sel);
            PG8_WAIT_V(8); PG8_WAIT_L(0); PG8_BAR; PG8_MMA(1, 0, At, B0); PG8_MMA(1, 1, At, B1); PG8_BAR; PG8_SCHED;
            PG8_LDB(B0, 1, 0); PG8_LDB(B1, 1, 1); PG8_SCHED; PG8_LDA(At, 1, 0); PG8_STAGE_A(PG8_SA(0, 1), a2, 1, sel);
            PG8_WAIT_V(8); PG8_WAIT_L(0); PG8_BAR; PG8_MMA(0, 0, At, B0); PG8_MMA(0, 1, At, B1); PG8_BAR; PG8_SCHED;
            PG8_LDA(At, 1, 1); PG8_STAGE(PG8_SB(1, 0), b3, voffB); PG8_STAGE(PG8_SB(1, 1), b3 + hstep, voffB); PG8_STAGE_A(PG8_SA(1, 0), a3, 0, sel);
            PG8_WAIT_V(8); PG8_WAIT_L(0); PG8_BAR; PG8_MMA(1, 0, At, B0); PG8_MMA(1, 1, At, B1); PG8_BAR; PG8_SCHED;
            } else {
            PG8_LDB(B0, 0, 0); PG8_SCHED; PG8_LDA(At, 0, 0); PG8_STAGE(PG8_SA(1, 1), a1 + hstep, voffA);
            PG8_WAIT_L(8); PG8_BAR; PG8_WAIT_L(0); PG8_MMA(0, 0, At, B0); PG8_BAR; PG8_SCHED;
            PG8_LDB(B1, 0, 1); PG8_STAGE(PG8_SB(0, 0), b2, voffB);
            PG8_BAR; PG8_WAIT_L(0); PG8_MMA(0, 1, At, B1); PG8_BAR;
            PG8_LDA(At, 0, 1); PG8_STAGE(PG8_SA(0, 0), a2, voffA);
            PG8_BAR; PG8_WAIT_L(0); PG8_MMA(1, 0, At, B0); PG8_BAR; PG8_SCHED;
            PG8_STAGE(PG8_SB(0, 1), b2 + hstep, voffB);
            PG8_WAIT_V(6); PG8_BAR; PG8_MMA(1, 1, At, B1); PG8_BAR;
            PG8_LDB(B0, 1, 0); PG8_SCHED; PG8_LDA(At, 1, 0); PG8_STAGE(PG8_SA(0, 1), a2 + hstep, voffA);
            PG8_WAIT_L(8); PG8_BAR; PG8_WAIT_L(0); PG8_MMA(0, 0, At, B0); PG8_BAR; PG8_SCHED;
            PG8_LDB(B1, 1, 1); PG8_STAGE(PG8_SB(1, 0), b3, voffB);
            PG8_BAR; PG8_WAIT_L(0); PG8_MMA(0, 1, At, B1); PG8_BAR;
            PG8_LDA(At, 1, 1); PG8_STAGE(PG8_SA(1, 0), a3, voffA);
            PG8_BAR; PG8_WAIT_L(0); PG8_MMA(1, 0, At, B0); PG8_BAR; PG8_SCHED;
            PG8_STAGE(PG8_SB(1, 1), b3 + hstep, voffB);
            PG8_WAIT_V(6); PG8_BAR; PG8_MMA(1, 1, At, B1); PG8_BAR;
            }
        }
        if constexpr (ALIGN_EPI) { if (wr == 0) PG8_BAR; }
        if constexpr (!Epi::AFTER_DRAIN) { E(acc, cur, wr, wc, fr, fq); S.done(cur); }
        if (!has_next) break;
#pragma unroll
        for (int a = 0; a < 2; ++a)
#pragma unroll
            for (int b = 0; b < 2; ++b)
#pragma unroll
                for (int m = 0; m < 4; ++m)
#pragma unroll
                    for (int n = 0; n < 2; ++n) acc[a][b][m][n] = (f32x4){0.f, 0.f, 0.f, 0.f};
        cur = nxt; cA = nA; cB = nB; ++ui;
        if constexpr (GATHER) { _Pragma("unroll") for (int _h = 0; _h < 2; ++_h) _Pragma("unroll") for (int _i = 0; _i < 2; ++_i) gvo[_h][_i] = ngvo[_h][_i]; }
        if constexpr (ALIGN_EPI) { if (wr == 1) PG8_BAR; }
    }
    PG8_WAIT_V(0);
    if constexpr (!ALIGN_EPI) { if (wr == 0) PG8_BAR; }
    PG8_BAR;
    if constexpr (Epi::AFTER_DRAIN) { E.fused(acc, cur, wr, wc, fr, fq, lds, wid, lane); S.done(cur); }
#undef PG8_SA
#undef PG8_SB
#undef PG8_STAGE
#undef PG8_STAGE_A
#undef PG8_GOFF
#undef PG8_LDA
#undef PG8_LDB
#undef PG8_MMA
#undef PG8_WAIT_V
#undef PG8_WAIT_L
#undef PG8_BAR
#undef PG8_SCHED
}
}

#ifndef PH_MASK
#define PH_MASK 0xffff
#endif
#ifndef PROBE_PHASE
#define PROBE_PHASE -1
#endif
constexpr int NWAVES = 8;
#ifndef MK_N_LAUNCHES
#define MK_N_LAUNCHES 1
#endif
constexpr int PER_PHASE = 13;
constexpr int N_LAUNCHES = MK_N_LAUNCHES;

constexpr size_t MiB = 1u << 20;
constexpr size_t WS_CTL = 0, CTL_ZERO_BYTES = 1 * MiB;
constexpr size_t WS_MOD = 1 * MiB;
constexpr size_t WS_WR = 1 * MiB + 65536;
constexpr size_t WS_KSUM = 262144;
constexpr size_t WS_ROUTE = 2 * MiB;
constexpr size_t WS_LIST = 3 * MiB;
constexpr size_t WS_WIN = 5 * MiB, WS_WBA = 13 * MiB, WS_WCOMB = 14 * MiB, WS_WOUT = 15 * MiB, WS_WGU = 18 * MiB, WS_WD = 82 * MiB;
constexpr size_t WS_H = 114 * MiB;
constexpr size_t WS_AO = WS_H, WS_DP = WS_H + 16 * MiB;
constexpr size_t WS_PROJ = 146 * MiB;
constexpr size_t WS_T = 146 * MiB;
constexpr size_t WS_XG = 146 * MiB;
constexpr size_t WS_ACT = 226 * MiB;
constexpr size_t WS_Y = 146 * MiB;
constexpr size_t WS_X1 = 266 * MiB;
constexpr size_t WS_END = 298 * MiB;
constexpr int CW_TMO = 0, CW_CODE = 1, CW_BAR = 4096, CW_ECNT = 16384;

constexpr int RING_OFF = 0, RING_BYTES = 131072;
constexpr int LDSCTL_OFF = RING_BYTES, MISC_OFF = LDSCTL_OFF + 320;
constexpr int TAB_OFF = LDSCTL_OFF + 512;
constexpr int BTAB_OFF = TAB_OFF, TOFF_OFF = TAB_OFF + 4096, ECNT_OFF = TOFF_OFF + 160, TILEE_OFF = ECNT_OFF + 128;
constexpr int LDS_BYTES = 147456;
static_assert(TILEE_OFF + 4 * MAXTILES <= LDS_BYTES, "LDS map");

using pg8::bf_lo; using pg8::bf_hi;
#define GAS __attribute__((address_space(1)))
#define LAS __attribute__((address_space(3)))
typedef unsigned short bf16;
typedef unsigned v4u __attribute__((ext_vector_type(4)));
typedef unsigned v2u __attribute__((ext_vector_type(2)));
typedef float f32x4 __attribute__((ext_vector_type(4)));
typedef GAS unsigned gu32;
#define RLX_AGENT __ATOMIC_RELAXED, __HIP_MEMORY_SCOPE_AGENT
#define LDS_WAIT() asm volatile("s_waitcnt lgkmcnt(0)" ::: "memory")
#define VM_WAIT() asm volatile("s_waitcnt vmcnt(0)" ::: "memory")
__device__ __forceinline__ unsigned f2bf(float f) { unsigned u = __builtin_bit_cast(unsigned, f); return (u + 0x7fffu + ((u >> 16) & 1u)) >> 16; }
__device__ __forceinline__ unsigned pk2(float lo, float hi) { return f2bf(lo) | (f2bf(hi) << 16); }
__device__ __forceinline__ float bf2f(bf16 v) { return __uint_as_float(((unsigned)v) << 16); }

#define XB_TMO      128
#define XB_XCNT(j)  (256  + 64 * (j))
#define XB_XSUB(j)  (1280 + 64 * (j))
#define XB_XGEN(j)  (2304 + 64 * (j))
#define XB_TOP      3328
#define XB_TOPGEN   3392
#define XCD_BAR_WORDS 3456
#define XB_SPIN_CAP (1u << 18)
__device__ __forceinline__ unsigned xb_ld(unsigned* p)              { return __hip_atomic_load(p, __ATOMIC_RELAXED, __HIP_MEMORY_SCOPE_AGENT); }
__device__ __forceinline__ unsigned xb_add(unsigned* p, unsigned v) { return __hip_atomic_fetch_add(p, v, __ATOMIC_RELAXED, __HIP_MEMORY_SCOPE_AGENT); }
__device__ __forceinline__ unsigned xb_xcc_id() { return (unsigned)__builtin_amdgcn_s_getreg((3 << 11) | 20) & 0xFu; }
#define XB_SPIN(cond, bar) do { unsigned _sp = 0; while (cond) { __builtin_amdgcn_s_sleep(1); \
    if ((++_sp & 255u) == 0u) { if (xb_ld(&(bar)[XB_TMO])) break; if (_sp > XB_SPIN_CAP) { atomicAdd(&(bar)[XB_TMO], 1u); break; } } } } while (0)

struct XcdBarrier {
    unsigned* bar; unsigned x;
    volatile LAS unsigned* st;
};

__device__ __forceinline__ XcdBarrier xcd_barrier_post(unsigned* bar, volatile LAS unsigned* st) {
    XcdBarrier b; b.bar = bar; b.x = xb_xcc_id(); b.st = st;
    if (threadIdx.x == 0) (void)xb_add(&bar[XB_XCNT(b.x)], 1u);
    return b;
}
__device__ __forceinline__ void xcd_barrier_complete(unsigned* bar, unsigned x, unsigned& nloc, unsigned& nx) {
    const unsigned G = gridDim.x * gridDim.y * gridDim.z;
    unsigned sum, cnt, mine, sp = 0u;
    for (;;) {
        sum = 0u; cnt = 0u; mine = 0u;
#pragma unroll
        for (unsigned j = 0; j < 16; ++j) { const unsigned c = xb_ld(&bar[XB_XCNT(j)]); sum += c; cnt += (c > 0u) ? 1u : 0u; mine = (j == x) ? c : mine; }
        if (sum == G) break;
        __builtin_amdgcn_s_sleep(1);
        if ((++sp & 255u) == 0u) { if (xb_ld(&bar[XB_TMO])) break; if (sp > XB_SPIN_CAP) { atomicAdd(&bar[XB_TMO], 1u); break; } }
    }
    nloc = mine > 0u ? mine : 1u; nx = cnt > 0u ? cnt : 1u;
}

__device__ __forceinline__ void xcd_barrier(const XcdBarrier& b) {
    asm volatile("s_waitcnt vmcnt(0)" ::: "memory");
    __syncthreads();
    if (threadIdx.x == 0) {
        unsigned* bar = b.bar;
        __builtin_amdgcn_s_waitcnt(0);
        unsigned nloc = b.st[0], nx = b.st[1];
        if (nloc == 0u) { xcd_barrier_complete(bar, b.x, nloc, nx); b.st[0] = nloc; b.st[1] = nx; }
        const unsigned old = xb_add(&bar[XB_XSUB(b.x)], 1u);
        const unsigned gen = old / nloc;
        if (old + 1u == (gen + 1u) * nloc) {
            __builtin_amdgcn_fence(__ATOMIC_RELEASE, "agent");
            asm volatile("s_waitcnt vmcnt(0)" ::: "memory");
            const unsigned og = xb_add(&bar[XB_TOP], 1u);
            const unsigned tg = og / nx;
            if (og + 1u == (tg + 1u) * nx) xb_add(&bar[XB_TOPGEN], 1u);
            else XB_SPIN(xb_ld(&bar[XB_TOPGEN]) == tg, bar);
            __builtin_amdgcn_fence(__ATOMIC_ACQUIRE, "agent");
            xb_add(&bar[XB_XGEN(b.x)], 1u);
            asm volatile("s_waitcnt vmcnt(0)" ::: "memory");
        } else {
            XB_SPIN(xb_ld(&bar[XB_XGEN(b.x)]) == gen, bar);
            __builtin_amdgcn_fence(__ATOMIC_ACQUIRE, "agent");
            asm volatile("s_waitcnt vmcnt(0)" ::: "memory");
        }
    }
    __syncthreads();
}

struct Args { const float* in[22]; float* out; unsigned char* ws; int ph_lo, ph_hi; };
struct Frame {
    LAS unsigned char* lds;
    volatile LAS unsigned* MISC;
    gu32* ctl;
    unsigned char* ws;
    int tid, lane, wave;
    int vcu, G;
    float* out;
};

__device__ __forceinline__ float wave_sum(float v) {
#pragma unroll
    for (int o = 1; o < 64; o <<= 1) v += __shfl_xor(v, o);
    return v;
}
__device__ __forceinline__ float wave_max(float v) {
#pragma unroll
    for (int o = 1; o < 64; o <<= 1) v = fmaxf(v, __shfl_xor(v, o));
    return v;
}

struct TrItem { const float* W; bf16* WT; int K, N, mode, item; };
__device__ __forceinline__ void tr_load(const TrItem& d, f32x4 (&v)[8], int lane) {
    const int nblk = d.N / 32, kb = d.item / nblk, nb = d.item % nblk, k0 = 64 * kb, n0 = 32 * nb;
#pragma unroll
    for (int i = 0; i < 8; ++i) v[i] = *(const f32x4*)(d.W + (size_t)(k0 + 8 * i + (lane >> 3)) * d.N + n0 + 4 * (lane & 7));
}
__device__ __forceinline__ void tr_store(const TrItem& d, const f32x4 (&v)[8], LAS float* scr, int lane) {
    const int nblk = d.N / 32, kb = d.item / nblk, nb = d.item % nblk, k0 = 64 * kb, n0 = 32 * nb;
#pragma unroll
    for (int i = 0; i < 8; ++i) { LAS float* p = scr + (8 * i + (lane >> 3)) * 33 + 4 * (lane & 7); p[0] = v[i].x; p[1] = v[i].y; p[2] = v[i].z; p[3] = v[i].w; }
    LDS_WAIT(); asm volatile("" ::: "memory");
    const int c = lane & 7;
#pragma unroll
    for (int j = 0; j < 4; ++j) { const int n = (lane >> 3) + 8 * j; const LAS float* s = scr + (8 * c) * 33 + n;
        v4u o; o.x = pk2(s[0 * 33], s[1 * 33]); o.y = pk2(s[2 * 33], s[3 * 33]); o.z = pk2(s[4 * 33], s[5 * 33]); o.w = pk2(s[6 * 33], s[7 * 33]);
        const int ng = n0 + n;
        const int drow = d.mode == 0 ? ng : (32 * (ng >> 4) + (ng & 15) + (d.mode == 2 ? 16 : 0));
        *(GAS v4u*)(d.WT + (size_t)drow * d.K + k0 + 8 * c) = o; }
    LDS_WAIT(); asm volatile("" ::: "memory");
}

__device__ __forceinline__ void p0_prologue(Frame& F, const Args& A) {
    {
        LAS float* cact = (LAS float*)(F.lds + RING_OFF);
        LAS float* part = cact + 2048;
        for (int i = F.tid; i < 2 * D; i += NWAVES * 64) { const float cv = A.in[1][i]; cact[i] = cv / (1.0f + __expf(-cv)); }
        __syncthreads();
        for (int ch = blockIdx.x; ch < (NMOD * D) / 64; ch += F.G) {
            const int n0 = ch * 64; float a0 = 0.f, a1 = 0.f;
            const float* wp = A.in[2] + (size_t)(F.wave * 128) * (NMOD * D) + n0 + F.lane;
#pragma unroll 8
            for (int k = 0; k < 128; ++k) { const float w = wp[(size_t)k * (NMOD * D)]; a0 += cact[F.wave * 128 + k] * w; a1 += cact[D + F.wave * 128 + k] * w; }
            part[(F.wave * 2 + 0) * 64 + F.lane] = a0; part[(F.wave * 2 + 1) * 64 + F.lane] = a1;
            __syncthreads();
            if (F.tid < 128) { const int b = F.tid >> 6, l = F.tid & 63; float s = 0.f;
#pragma unroll
                for (int w = 0; w < 8; ++w) s += part[(w * 2 + b) * 64 + l];
                ((float*)(F.ws + WS_MOD))[b * (NMOD * D) + n0 + l] = s + A.in[3][n0 + l]; }
            __syncthreads();
        }
        __syncthreads();
    }
    LAS float* scr = (LAS float*)(F.lds + RING_OFF + F.wave * 16384);
    const int gw = F.vcu * NWAVES + F.wave, NGW = F.G * NWAVES;
    {
        bf16* WcT = (bf16*)(F.ws + WS_WCOMB); const float* pw = A.in[8]; const float* ps = A.in[9]; const float* wbp = A.in[11];
        for (int it = gw; it < (PW / 8) * (D / 64); it += NGW) {
            const int c0 = (it >> 4) * 8, n = (it & 15) * 64 + F.lane, g = c0 >> 7;
            float a[8];
#pragma unroll
            for (int i = 0; i < 8; ++i) a[i] = 0.f;
            for (int d = 0; d < PGW; ++d) { const float wv = wbp[(size_t)(g * PGW + d) * D + n] * ps[g * PGW + d];
#pragma unroll
                for (int i = 0; i < 8; ++i) a[i] += pw[(size_t)(g * PGW + (c0 & 127) + i) * PGW + d] * wv; }
            v4u o; o.x = pk2(a[0], a[1]); o.y = pk2(a[2], a[3]); o.z = pk2(a[4], a[5]); o.w = pk2(a[6], a[7]);
            *(v4u*)(WcT + (size_t)n * PW + c0) = o; }
    }
    {
        bf16* Wh = (bf16*)(F.ws + WS_WR); bf16* Wl = Wh + 48 * D; const float* w_rg = A.in[14]; const float* w_re = A.in[16];
        for (int i = gw * 64 + F.lane; i < 48 * D; i += NGW * 64) { const int n = i >> 10, k = i & (D - 1);
            const float w = n < 32 ? w_re[(size_t)k * NE + n] : (n < 36 ? w_rg[(size_t)k * 4 + (n - 32)] : 0.f);
            const unsigned hb = f2bf(w); const float hf = __uint_as_float(hb << 16);
            Wh[i] = (bf16)hb; Wl[i] = (bf16)f2bf(w - hf); }
    }
    constexpr int I_IN = (D / 64) * (INW / 32), I_BA = (AW / 64) * (D / 32), I_BP = (PW / 64) * (D / 32), I_OUT = (D / 64) * (D / 32);
    constexpr int I_EG = (D / 64) * (DE / 32), I_ED = (DE / 64) * (D / 32);
    constexpr int NITEMS = I_IN + I_BA + I_OUT + NE * (2 * I_EG + I_ED);
    bf16* WinT = (bf16*)(F.ws + WS_WIN); bf16* WbaT = (bf16*)(F.ws + WS_WBA); bf16* WoutT = (bf16*)(F.ws + WS_WOUT);
    bf16* WguT = (bf16*)(F.ws + WS_WGU); bf16* WdT = (bf16*)(F.ws + WS_WD);
    auto decode = [&](int it) -> TrItem { TrItem d; int r = it;
        if (r < I_IN) { d.W = A.in[5]; d.WT = WinT; d.K = D; d.N = INW; d.mode = 0; d.item = r; return d; } r -= I_IN;
        if (r < I_BA) { d.W = A.in[10]; d.WT = WbaT; d.K = AW; d.N = D; d.mode = 0; d.item = r; return d; } r -= I_BA;
        if (r < I_OUT) { d.W = A.in[12]; d.WT = WoutT; d.K = D; d.N = D; d.mode = 0; d.item = r; return d; } r -= I_OUT;
        if (r < NE * I_EG) { const int e = r / I_EG; d.W = A.in[18] + (size_t)e * D * DE; d.WT = WguT + (size_t)e * D * D; d.K = D; d.N = DE; d.mode = 1; d.item = r % I_EG; return d; } r -= NE * I_EG;
        if (r < NE * I_EG) { const int e = r / I_EG; d.W = A.in[19] + (size_t)e * D * DE; d.WT = WguT + (size_t)e * D * D; d.K = D; d.N = DE; d.mode = 2; d.item = r % I_EG; return d; } r -= NE * I_EG;
        { const int e = r / I_ED; d.W = A.in[20] + (size_t)e * DE * D; d.WT = WdT + (size_t)e * D * DE; d.K = DE; d.N = D; d.mode = 0; d.item = r % I_ED; return d; } };
    if (gw < NITEMS) {
        TrItem cur = decode(gw); f32x4 va[8], vb[8]; tr_load(cur, va, F.lane);
        for (int it = gw; it < NITEMS; it += NGW) {
            const bool more = it + NGW < NITEMS; TrItem nxt = cur;
            if (more) { nxt = decode(it + NGW); tr_load(nxt, vb, F.lane); }
            tr_store(cur, va, scr, F.lane);
            cur = nxt;
#pragma unroll
            for (int i = 0; i < 8; ++i) va[i] = vb[i];
        }
    }
}


__device__ __forceinline__ void p1_hrows(Frame& F, const Args& A) {
    const int gw = F.vcu * NWAVES + F.wave, NGW = F.G * NWAVES;
    const float* mod = (const float*)(F.ws + WS_MOD); bf16* H = (bf16*)(F.ws + WS_H);
    for (int m0 = gw * 4; m0 < NTOK; m0 += NGW * 4) {
        const float* md = mod + (m0 / SEQ) * (NMOD * D);
        f32x4 v[4][4];
#pragma unroll
        for (int r = 0; r < 4; ++r) { const f32x4* xr = (const f32x4*)(A.in[0] + (size_t)(m0 + r) * D) + F.lane;
#pragma unroll
            for (int j = 0; j < 4; ++j) v[r][j] = xr[64 * j]; }
        float rstd[4];
#pragma unroll
        for (int r = 0; r < 4; ++r) { float ss = 0.f;
#pragma unroll
            for (int j = 0; j < 4; ++j) ss += (v[r][j].x * v[r][j].x + v[r][j].y * v[r][j].y) + (v[r][j].z * v[r][j].z + v[r][j].w * v[r][j].w);
            rstd[r] = 1.0f / sqrtf(wave_sum(ss) * (1.0f / D) + EPS); }
#pragma unroll
        for (int j = 0; j < 4; ++j) { const int col = 4 * F.lane + 256 * j;
            const f32x4 g = *(const f32x4*)(A.in[4] + col), sh = *(const f32x4*)(md + col), sc = *(const f32x4*)(md + D + col);
            const f32x4 gs = g * (sc + 1.0f);
#pragma unroll
            for (int r = 0; r < 4; ++r) { const f32x4 hh = (v[r][j] * rstd[r]) * gs + sh;
                v2u o; o.x = pk2(hh.x, hh.y); o.y = pk2(hh.z, hh.w);
                *(v2u*)(H + (size_t)(m0 + r) * D + col) = o; } }
    }
}

__device__ __forceinline__ void p3_pooldiff(Frame& F, const Args& A) {
    const int gw = F.vcu * NWAVES + F.wave, NGW = F.G * NWAVES, lane = F.lane;
    const bf16* Ut = (const bf16*)(F.ws + WS_PROJ) + (size_t)3 * NTOK * 512;
    bf16* DP = (bf16*)(F.ws + WS_DP);
    const int w = 2 << (lane >> 4);
    for (int m0 = gw * 8; m0 < NTOK; m0 += NGW * 8) {
        const int t0 = m0 & (SEQ - 1);
        const bf16* up = Ut + (size_t)m0 * 512 + 8 * lane;
        v4u vv[23];
#pragma unroll
        for (int i = 0; i < 23; ++i) { vv[i] = (v4u){0u, 0u, 0u, 0u}; if (t0 + i - 15 >= 0) vv[i] = *(const v4u*)(up + (ptrdiff_t)(i - 15) * 512); }
#pragma unroll
        for (int r = 0; r < 8; ++r) { const int t = t0 + r; const int cnt = (t + 1) < w ? (t + 1) : w;
            float s[8];
#pragma unroll
            for (int i = 0; i < 8; ++i) s[i] = 0.f;
#pragma unroll
            for (int k = 0; k < 16; ++k) { if (k < cnt) { const v4u v = vv[r + 15 - k];
                s[0] += bf_lo(v.x); s[1] += bf_hi(v.x); s[2] += bf_lo(v.y); s[3] += bf_hi(v.y); s[4] += bf_lo(v.z); s[5] += bf_hi(v.z); s[6] += bf_lo(v.w); s[7] += bf_hi(v.w); } }
            const v4u u0 = vv[r + 15]; const float inv = 1.0f / (float)cnt;
            v4u o; o.x = pk2(s[0] * inv - bf_lo(u0.x), s[1] * inv - bf_hi(u0.x)); o.y = pk2(s[2] * inv - bf_lo(u0.y), s[3] * inv - bf_hi(u0.y));
            o.z = pk2(s[4] * inv - bf_lo(u0.z), s[5] * inv - bf_hi(u0.z)); o.w = pk2(s[6] * inv - bf_lo(u0.w), s[7] * inv - bf_hi(u0.w));
            *(v4u*)(DP + (size_t)(m0 + r) * 512 + 8 * lane) = o; }
    }
}

__device__ __forceinline__ void build_btab(Frame& F, const Args& A) {
    LAS float* btab = (LAS float*)(F.lds + BTAB_OFF);
    for (int i = F.tid; i < NH * 128; i += NWAVES * 64) { const int h = i >> 7, rel = i & 127; int bk;
        if (rel < 16) bk = rel;
        else { bk = 16; const int th[15] = {19, 21, 24, 27, 31, 35, 40, 46, 52, 59, 67, 77, 87, 99, 113};
#pragma unroll
            for (int q = 0; q < 15; ++q) bk += (rel >= th[q]) ? 1 : 0; }
        btab[i] = A.in[7][bk * NH + h]; }
    __syncthreads();
}

__device__ __forceinline__ void p4_attn_naive(Frame& F, const Args& A) {
    build_btab(F, A);
    const int gw = F.vcu * NWAVES + F.wave, NGW = F.G * NWAVES;
    const bf16* Qt = (const bf16*)(F.ws + WS_PROJ);
    const bf16* Kt = Qt + (size_t)1 * NTOK * 512;
    const bf16* Vt = Qt + (size_t)2 * NTOK * 512;
    const float* kmean = (const float*)(F.ws + WS_KSUM);
    bf16* AO = (bf16*)(F.ws + WS_AO);
    const LAS float* btab = (const LAS float*)(F.lds + BTAB_OFF);
    LAS float* qs = (LAS float*)(F.lds + RING_OFF + F.wave * 8192);
    LAS float* ps = qs + 64;
    const int lane = F.lane;
    for (int it = gw; it < NTOK * NH; it += NGW) {
        const int h = it & 7, m = it >> 3, b = m / SEQ, t = m & (SEQ - 1), blk = t >> 8;
        qs[lane] = bf2f(Qt[(size_t)m * 512 + h * HD + lane]);
        LDS_WAIT(); asm volatile("" ::: "memory");
        float q[64];
#pragma unroll
        for (int d4 = 0; d4 < 16; ++d4) { const f32x4 v = *(const LAS f32x4*)(qs + 4 * d4); q[4 * d4] = v.x; q[4 * d4 + 1] = v.y; q[4 * d4 + 2] = v.z; q[4 * d4 + 3] = v.w; }
        float sc = -3.0e38f;
        if (lane < blk) { const f32x4* km = (const f32x4*)(kmean + (size_t)((b * NH + h) * NBLK + lane) * HD); float s = 0.f;
#pragma unroll
            for (int d4 = 0; d4 < 16; ++d4) { const f32x4 kv = km[d4]; s += q[4 * d4] * kv.x + q[4 * d4 + 1] * kv.y + q[4 * d4 + 2] * kv.z + q[4 * d4 + 3] * kv.w; }
            sc = s; }
        int sel[3];
#pragma unroll
        for (int i = 0; i < 3; ++i) { const float mx = wave_max(sc); const unsigned long long mk = __ballot(sc == mx && lane < blk);
            const int idx = mk ? (int)__builtin_ctzll(mk) : 0; sel[i] = idx; if (lane == idx) sc = -3.0e38f; }
        const int nsel = blk < 3 ? blk : 3;
        float lg[4][4];
#pragma unroll
        for (int s = 0; s < 4; ++s) {
            const bool valid = (s == 3) || (s < nsel);
            const int jb = (s == 3) ? blk : sel[s < 3 ? s : 0];
#pragma unroll
            for (int i = 0; i < 4; ++i) {
                float lgt = NEG_INF;
                if (valid) { const int kk = lane + 64 * i, kpos = jb * MBLK + kk;
                    const v4u* kr = (const v4u*)(Kt + (size_t)(b * SEQ + kpos) * 512 + h * HD); float dsum = 0.f;
#pragma unroll
                    for (int c8 = 0; c8 < 8; ++c8) { const v4u kv = kr[c8];
                        dsum += q[8 * c8 + 0] * __uint_as_float(kv.x << 16) + q[8 * c8 + 1] * __uint_as_float(kv.x & 0xffff0000u)
                              + q[8 * c8 + 2] * __uint_as_float(kv.y << 16) + q[8 * c8 + 3] * __uint_as_float(kv.y & 0xffff0000u)
                              + q[8 * c8 + 4] * __uint_as_float(kv.z << 16) + q[8 * c8 + 5] * __uint_as_float(kv.z & 0xffff0000u)
                              + q[8 * c8 + 6] * __uint_as_float(kv.w << 16) + q[8 * c8 + 7] * __uint_as_float(kv.w & 0xffff0000u); }
                    const int rel = t - kpos;
                    if (rel >= 0) lgt = dsum * 0.125f + btab[h * 128 + (rel > 127 ? 127 : rel)]; }
                lg[s][i] = lgt; }
        }
        float mx = NEG_INF;
#pragma unroll
        for (int s = 0; s < 4; ++s)
#pragma unroll
            for (int i = 0; i < 4; ++i) mx = fmaxf(mx, lg[s][i]);
        mx = wave_max(mx);
        float sum = 0.f;
#pragma unroll
        for (int s = 0; s < 4; ++s)
#pragma unroll
            for (int i = 0; i < 4; ++i) { const float e = (lg[s][i] <= -1e29f) ? 0.f : __expf(lg[s][i] - mx); lg[s][i] = e; sum += e; }
        sum = wave_sum(sum);
        const float inv = 1.0f / sum;
#pragma unroll
        for (int s = 0; s < 4; ++s)
#pragma unroll
            for (int i = 0; i < 4; ++i) ps[s * 256 + lane + 64 * i] = lg[s][i] * inv;
        LDS_WAIT(); asm volatile("" ::: "memory");
        float o = 0.f;
#pragma unroll
        for (int s = 0; s < 4; ++s) {
            const bool valid = (s == 3) || (s < nsel);
            if (valid) { const int jb = (s == 3) ? blk : sel[s < 3 ? s : 0];
                const int nk = (s == 3) ? (((t & 255) + 4) & ~3) : 256;
                const bf16* vp = Vt + (size_t)(b * SEQ + jb * MBLK) * 512 + h * HD + lane;
                for (int kk = 0; kk < nk; kk += 4) { const f32x4 p4 = *(const LAS f32x4*)(ps + s * 256 + kk);
                    o += p4.x * bf2f(vp[(size_t)(kk + 0) * 512]) + p4.y * bf2f(vp[(size_t)(kk + 1) * 512]) + p4.z * bf2f(vp[(size_t)(kk + 2) * 512]) + p4.w * bf2f(vp[(size_t)(kk + 3) * 512]); } }
        }
        AO[(size_t)m * 512 + h * HD + lane] = (bf16)f2bf(o);
        LDS_WAIT(); asm volatile("" ::: "memory");
    }
}

__device__ __forceinline__ void p8_norm_route(Frame& F, const Args& A) {
    typedef short bf16x8 __attribute__((ext_vector_type(8)));
    const int lane = F.lane, w = F.wave, tile = w >> 2, kq = w & 3, r = lane & 15, kg = lane >> 4;
    const float* mod = (const float*)(F.ws + WS_MOD); bf16* H2 = (bf16*)(F.ws + WS_H);
    int* route = (int*)(F.ws + WS_ROUTE); int* list = (int*)(F.ws + WS_LIST);
    const bf16* Wh = (const bf16*)(F.ws + WS_WR); const bf16* Wl = Wh + 48 * D;
    LAS float* avec = (LAS float*)(F.lds + RING_OFF); LAS float* cvec = avec + D; LAS float* ssp = cvec + D;
    LAS float* zt = ssp + 128;
    LAS int* lcnt = (LAS int*)(zt + 2 * 4 * 16 * 48); LAS int* gbase = lcnt + 32; LAS int* tinfo = gbase + 32;
    const float bias = lane < 32 ? A.in[17][lane] : (lane < 36 ? A.in[15][lane - 32] : 0.f);
    const int kl = kq * 256 + 8 * kg;
    const bf16* wbh[3]; const bf16* wbl[3];
#pragma unroll
    for (int nt = 0; nt < 3; ++nt) { wbh[nt] = Wh + (size_t)(16 * nt + r) * D + kl; wbl[nt] = Wl + (size_t)(16 * nt + r) * D + kl; }
    const LAS float* ap = avec + kl; const LAS float* cp = cvec + kl;
    int bprev = -1;
    for (int it = blockIdx.x * 2; it < NTOK / 32; it += F.G * 2) {
#pragma unroll 1
      for (int sub = 0; sub < 2; ++sub) {
        const int mbase = (it + sub) * 32; const int bcur = mbase / SEQ; const float* md = mod + bcur * (NMOD * D);
        const int m = mbase + 16 * tile + r;
        const v4u* xr = (const v4u*)((const bf16*)(F.ws + WS_X1) + (size_t)m * D + kl);
        f32x4 xa[8], xb[8];
#pragma unroll
        for (int ks = 0; ks < 8; ++ks) { const v4u xv = xr[4 * ks]; xa[ks] = (f32x4){bf_lo(xv.x), bf_hi(xv.x), bf_lo(xv.y), bf_hi(xv.y)}; xb[ks] = (f32x4){bf_lo(xv.z), bf_hi(xv.z), bf_lo(xv.w), bf_hi(xv.w)}; }
        __syncthreads();
        if (bcur != bprev) { for (int k = F.tid; k < D; k += NWAVES * 64) { avec[k] = A.in[13][k] * (1.0f + md[4 * D + k]); cvec[k] = md[3 * D + k]; } bprev = bcur; }
        if (F.tid < 32) lcnt[F.tid] = 0;
        float ss = 0.f;
#pragma unroll
        for (int ks = 0; ks < 8; ++ks) ss += (xa[ks].x * xa[ks].x + xa[ks].y * xa[ks].y) + (xa[ks].z * xa[ks].z + xa[ks].w * xa[ks].w) + (xb[ks].x * xb[ks].x + xb[ks].y * xb[ks].y) + (xb[ks].z * xb[ks].z + xb[ks].w * xb[ks].w);
        ss += __shfl_xor(ss, 16); ss += __shfl_xor(ss, 32);
        if (kg == 0) ssp[w * 16 + r] = ss;
        __syncthreads();
        const float rstd = 1.0f / sqrtf(((ssp[(tile * 4 + 0) * 16 + r] + ssp[(tile * 4 + 1) * 16 + r]) + (ssp[(tile * 4 + 2) * 16 + r] + ssp[(tile * 4 + 3) * 16 + r])) * (1.0f / D) + EPS);
        f32x4 acc[3];
#pragma unroll
        for (int nt = 0; nt < 3; ++nt) acc[nt] = (f32x4){0.f, 0.f, 0.f, 0.f};
        bf16* h2p = H2 + (size_t)m * D + kl;
#pragma unroll
        for (int ks = 0; ks < 8; ++ks) {
            if ((ks & 3) == 0) asm volatile("" ::: "memory");
            const f32x4 a0 = *(const LAS f32x4*)(ap + 32 * ks), a1 = *(const LAS f32x4*)(ap + 32 * ks + 4), c0 = *(const LAS f32x4*)(cp + 32 * ks), c1 = *(const LAS f32x4*)(cp + 32 * ks + 4);
            const f32x4 h0 = (xa[ks] * rstd) * a0 + c0, h1 = (xb[ks] * rstd) * a1 + c1;
            v4u hb; hb.x = pk2(h0.x, h0.y); hb.y = pk2(h0.z, h0.w); hb.z = pk2(h1.x, h1.y); hb.w = pk2(h1.z, h1.w);
            *(v4u*)(h2p + 32 * ks) = hb;
            v4u lb; lb.x = pk2(h0.x - bf_lo(hb.x), h0.y - bf_hi(hb.x)); lb.y = pk2(h0.z - bf_lo(hb.y), h0.w - bf_hi(hb.y)); lb.z = pk2(h1.x - bf_lo(hb.z), h1.y - bf_hi(hb.z)); lb.w = pk2(h1.z - bf_lo(hb.w), h1.w - bf_hi(hb.w));
            const bf16x8 ah = __builtin_bit_cast(bf16x8, hb), al = __builtin_bit_cast(bf16x8, lb);
#pragma unroll
            for (int nt = 0; nt < 3; ++nt) { const bf16x8 bh = *(const bf16x8*)(wbh[nt] + 32 * ks), bl = *(const bf16x8*)(wbl[nt] + 32 * ks);
                acc[nt] = __builtin_amdgcn_mfma_f32_16x16x32_bf16(ah, bh, acc[nt], 0, 0, 0);
                acc[nt] = __builtin_amdgcn_mfma_f32_16x16x32_bf16(ah, bl, acc[nt], 0, 0, 0);
                acc[nt] = __builtin_amdgcn_mfma_f32_16x16x32_bf16(al, bh, acc[nt], 0, 0, 0); } }
#pragma unroll
        for (int nt = 0; nt < 3; ++nt)
#pragma unroll
            for (int q = 0; q < 4; ++q) zt[((tile * 4 + kq) * 16 + 4 * kg + q) * 48 + 16 * nt + r] = acc[nt][q];
        __syncthreads();
#pragma unroll 1
        for (int i = 0; i < 4; ++i) { const int tok = 4 * w + i, tt = tok >> 4, tr = tok & 15, lz = lane < 48 ? lane : 47;
            const LAS float* zp = zt + ((tt * 4) * 16 + tr) * 48 + lz;
            const float z = ((zp[0] + zp[16 * 48]) + (zp[2 * 16 * 48] + zp[3 * 16 * 48])) + bias;
            const bool isg = lane >= 32 && lane < 36;
            const float vg = isg ? z : -3.0e38f;
            const float gm = wave_max(vg);
            const int gi = (int)__builtin_ctzll(__ballot(isg && vg == gm)) - 32;
            const float gs = wave_sum(isg ? __expf(vg - gm) : 0.f);
            const float pg = 1.0f / gs;
            const bool ing = lane < 32 && (lane >> 3) == gi;
            const float ve = ing ? z : -3.0e38f;
            const float e0m = wave_max(ve);
            const int ex0 = (int)__builtin_ctzll(__ballot(ing && ve == e0m));
            const float ve2 = (lane == ex0) ? -3.0e38f : ve;
            const float e1m = wave_max(ve2);
            const int ex1 = (int)__builtin_ctzll(__ballot(ing && lane != ex0 && ve2 == e1m));
            const float e1 = __expf(e1m - e0m); const float w0 = pg / (1.0f + e1), w1 = pg * e1 / (1.0f + e1);
            if (lane == 0) { const int lp0 = __hip_atomic_fetch_add(lcnt + ex0, 1, __ATOMIC_RELAXED, __HIP_MEMORY_SCOPE_WORKGROUP), lp1 = __hip_atomic_fetch_add(lcnt + ex1, 1, __ATOMIC_RELAXED, __HIP_MEMORY_SCOPE_WORKGROUP);
                LAS int* ti = tinfo + tok * 8; ti[0] = ex0; ti[1] = ex1; ti[2] = lp0; ti[3] = lp1; ti[4] = __float_as_int(w0); ti[5] = __float_as_int(w1); } }
        __syncthreads();
        if (F.tid < 32) { const int c = lcnt[F.tid]; gbase[F.tid] = c ? (int)__hip_atomic_fetch_add((unsigned*)(F.ctl + CW_ECNT + 64 * F.tid), (unsigned)c, RLX_AGENT) : 0; }
        __syncthreads();
        if (F.tid < 32) { const LAS int* ti = tinfo + F.tid * 8; const int ex0 = ti[0], ex1 = ti[1], p0 = gbase[ex0] + ti[2], p1 = gbase[ex1] + ti[3], mm = mbase + F.tid;
            list[(size_t)ex0 * NTOK + p0] = mm; list[(size_t)ex1 * NTOK + p1] = mm;
            int* rt = route + (size_t)mm * 8; rt[0] = ex0; rt[1] = ex1; rt[2] = p0; rt[3] = p1; rt[4] = ti[4]; rt[5] = ti[5]; }
      }
    }
    __syncthreads();
}

__device__ __forceinline__ void build_tables(Frame& F) {
    LAS int* toff = (LAS int*)(F.lds + TOFF_OFF); LAS int* ecnt = (LAS int*)(F.lds + ECNT_OFF); LAS int* tile_e = (LAS int*)(F.lds + TILEE_OFF);
    __syncthreads();
    if (F.tid < NE) ecnt[F.tid] = (int)__hip_atomic_load((unsigned*)(F.ctl + CW_ECNT + 64 * F.tid), RLX_AGENT);
    __syncthreads();
    if (F.tid == 0) { int o = 0; for (int e = 0; e < NE; ++e) { toff[e] = o; const int nt = (ecnt[e] + 255) >> 8; for (int k = 0; k < nt; ++k) tile_e[o + k] = e; o += nt; } toff[NE] = o; }
    __syncthreads();
}

__device__ __forceinline__ void p8_gather(Frame& F, const Args& A) {
    build_tables(F);
    const int gw = F.vcu * NWAVES + F.wave, NGW = F.G * NWAVES;
    const LAS int* toff = (const LAS int*)(F.lds + TOFF_OFF); const LAS int* ecnt = (const LAS int*)(F.lds + ECNT_OFF); const LAS int* tile_e = (const LAS int*)(F.lds + TILEE_OFF);
    const bf16* H2 = (const bf16*)(F.ws + WS_H); bf16* XG = (bf16*)(F.ws + WS_XG); const int* list = (const int*)(F.ws + WS_LIST);
    const int nrows = toff[NE] * 256;
    for (int r = gw; r < nrows; r += NGW) {
        const int e = tile_e[r >> 8], p = r - toff[e] * 256;
        v4u a = (v4u){0u, 0u, 0u, 0u}, bq = a;
        if (p < ecnt[e]) { const int tok = list[(size_t)e * NTOK + p]; const v4u* src = (const v4u*)(H2 + (size_t)tok * D); a = src[F.lane]; bq = src[F.lane + 64]; }
        v4u* dst = (v4u*)(XG + (size_t)r * D); dst[F.lane] = a; dst[F.lane + 64] = bq;
    }
}

__device__ __forceinline__ void p11_final(Frame& F, const Args& A) {
    build_tables(F);
    const int gw = F.vcu * NWAVES + F.wave, NGW = F.G * NWAVES;
    const LAS int* toff = (const LAS int*)(F.lds + TOFF_OFF);
    const float* mod = (const float*)(F.ws + WS_MOD); const bf16* Y = (const bf16*)(F.ws + WS_Y); const int* route = (const int*)(F.ws + WS_ROUTE);
    for (int m0 = gw * 4; m0 < NTOK; m0 += NGW * 4) {
        const float* md = mod + (m0 / SEQ) * (NMOD * D);
        size_t r0[4], r1[4]; float w0[4], w1[4];
#pragma unroll
        for (int r = 0; r < 4; ++r) { const v4u ra = *(const v4u*)(route + (size_t)(m0 + r) * 8); const v2u rb = *(const v2u*)(route + (size_t)(m0 + r) * 8 + 4);
            r0[r] = (size_t)toff[ra.x] * 256 + ra.z; r1[r] = (size_t)toff[ra.y] * 256 + ra.w; w0[r] = __uint_as_float(rb.x); w1[r] = __uint_as_float(rb.y); }
        f32x4 v[4][4]; v2u ya[4][4], yb[4][4];
#pragma unroll
        for (int r = 0; r < 4; ++r) { const v2u* xr = (const v2u*)((const bf16*)(F.ws + WS_X1) + (size_t)(m0 + r) * D) + F.lane;
#pragma unroll
            for (int j = 0; j < 4; ++j) { const int col = 4 * F.lane + 256 * j; const v2u xv = xr[64 * j]; v[r][j] = (f32x4){bf_lo(xv.x), bf_hi(xv.x), bf_lo(xv.y), bf_hi(xv.y)}; ya[r][j] = *(const v2u*)(Y + r0[r] * D + col); yb[r][j] = *(const v2u*)(Y + r1[r] * D + col); } }
        float rstd[4];
#pragma unroll
        for (int r = 0; r < 4; ++r) { float ss = 0.f;
#pragma unroll
            for (int j = 0; j < 4; ++j) { const int col = 4 * F.lane + 256 * j; const f32x4 g2 = *(const f32x4*)(md + 5 * D + col); const v2u y0 = ya[r][j], y1 = yb[r][j];
                f32x4 yy; yy.x = w0[r] * bf_lo(y0.x) + w1[r] * bf_lo(y1.x); yy.y = w0[r] * bf_hi(y0.x) + w1[r] * bf_hi(y1.x); yy.z = w0[r] * bf_lo(y0.y) + w1[r] * bf_lo(y1.y); yy.w = w0[r] * bf_hi(y0.y) + w1[r] * bf_hi(y1.y);
                v[r][j] = v[r][j] + g2 * yy;
                ss += (v[r][j].x * v[r][j].x + v[r][j].y * v[r][j].y) + (v[r][j].z * v[r][j].z + v[r][j].w * v[r][j].w); }
            rstd[r] = 1.0f / sqrtf(wave_sum(ss) * (1.0f / D) + EPS); }
#pragma unroll
        for (int j = 0; j < 4; ++j) { const int col = 4 * F.lane + 256 * j; const f32x4 g = *(const f32x4*)(A.in[21] + col);
#pragma unroll
            for (int r = 0; r < 4; ++r) *((f32x4*)(F.out + (size_t)(m0 + r) * D) + F.lane + 64 * j) = (v[r][j] * rstd[r]) * g; }
    }
}


namespace att {
typedef float f32x16 __attribute__((ext_vector_type(16)));
typedef short bf16x8 __attribute__((ext_vector_type(8)));
typedef short s16x4 __attribute__((ext_vector_type(4)));
typedef short v4i16_t __attribute__((ext_vector_type(4)));
constexpr float LOG2E = 1.4426950408889634f, C2 = 0.125f * LOG2E;
constexpr int KIMG = 0, VIMG = 32768, LIST_OFF = 65536, CNT_OFF = 73728, WSF_OFF = 73728 + 256;
constexpr size_t PLANE = (size_t)NTOK * NH * HD;
__device__ __forceinline__ int crow(int r, int hi) { return (r & 3) + 8 * (r >> 2) + 4 * hi; }
__device__ __forceinline__ s16x4 vtr(const LAS unsigned char* p) { return __builtin_bit_cast(s16x4, __builtin_amdgcn_ds_read_tr16_b64_v4i16((LAS v4i16_t*)p)); }
__device__ __forceinline__ float swap_max(float v) { auto rr = __builtin_amdgcn_permlane32_swap(__float_as_uint(v), __float_as_uint(v), false, false); return fmaxf(__uint_as_float(rr[0]), __uint_as_float(rr[1])); }
__device__ __forceinline__ float swap_sum(float v) { auto rr = __builtin_amdgcn_permlane32_swap(__float_as_uint(v), __float_as_uint(v), false, false); return __uint_as_float(rr[0]) + __uint_as_float(rr[1]); }

__device__ __forceinline__ void load_kv(LAS unsigned char* lds, const bf16* Kt, const bf16* Vt, int b, int h, int jb, int tid, int wave) {
    const bf16* kb = Kt + (size_t)(b * SEQ + jb * MBLK) * 512 + h * HD;
    const bf16* vb = Vt + (size_t)(b * SEQ + jb * MBLK) * 512 + h * HD;
#pragma unroll
    for (int i = 0; i < 4; ++i) { const int g = tid + 512 * i, row = g >> 3, cp = g & 7;
        const int ck = cp ^ ((row >> 1) & 7);
        __builtin_amdgcn_global_load_lds((const unsigned*)(kb + (size_t)row * 512 + ck * 8), (LAS unsigned*)(lds + KIMG + wave * 1024 + i * 8192), 16, 0, 0);
        const int dv = (((cp >> 2) ^ ((row >> 1) & 1)) << 5) + ((cp & 3) << 3);
        __builtin_amdgcn_global_load_lds((const unsigned*)(vb + (size_t)row * 512 + dv), (LAS unsigned*)(lds + VIMG + wave * 1024 + i * 8192), 16, 0, 0); }
}

__device__ __forceinline__ void qk_tile(f32x16& S, const LAS unsigned char* lds, int kt, const int (&kb)[4], const bf16x8 (&qr)[4]) {
    f32x16 acc = {};
#pragma unroll
    for (int d0 = 0; d0 < 4; ++d0) { const bf16x8 kf = *(const LAS bf16x8*)(lds + KIMG + kt * 4096 + kb[d0]); acc = __builtin_amdgcn_mfma_f32_32x32x16_bf16(kf, qr[d0], acc, 0, 0, 0); }
    S = acc;
}
__device__ __forceinline__ bf16x8 pack_p(const f32x16& P, int s) {
    pg8::u32x4 w; w.x = pg8::cvt_pk_bf16(P[8 * s + 0], P[8 * s + 1]); w.y = pg8::cvt_pk_bf16(P[8 * s + 2], P[8 * s + 3]); w.z = pg8::cvt_pk_bf16(P[8 * s + 4], P[8 * s + 5]); w.w = pg8::cvt_pk_bf16(P[8 * s + 6], P[8 * s + 7]);
    return __builtin_bit_cast(bf16x8, w);
}
__device__ __forceinline__ void pv_tile(f32x16& o0, f32x16& o1, const f32x16& P, const LAS unsigned char* lds, int kt, int vb0, int vb1) {
#pragma unroll
    for (int s = 0; s < 2; ++s) { const bf16x8 pa = pack_p(P, s); const int off = VIMG + (32 * kt + 16 * s) * 128;
        const s16x4 l0 = vtr(lds + off + vb0), h0 = vtr(lds + off + 1024 + vb0), l1 = vtr(lds + off + vb1), h1 = vtr(lds + off + 1024 + vb1);
        const bf16x8 b0 = (bf16x8){l0[0], l0[1], l0[2], l0[3], h0[0], h0[1], h0[2], h0[3]}, b1 = (bf16x8){l1[0], l1[1], l1[2], l1[3], h1[0], h1[1], h1[2], h1[3]};
        o0 = __builtin_amdgcn_mfma_f32_32x32x16_bf16(b0, pa, o0, 0, 0, 0); o1 = __builtin_amdgcn_mfma_f32_32x32x16_bf16(b1, pa, o1, 0, 0, 0); }
}

struct SelUnit { unsigned char j, qlo, qhi, pad; };
constexpr int SU_MAX = 256;
struct SelTable { SelUnit u[SU_MAX]; int n; };
constexpr float su_expect(int qb) { return 256.f * (qb < 3 ? (float)qb : 3.f) / (float)qb; }
constexpr SelTable make_sel_table() {
    SelTable T{}; float ex[SU_MAX] = {}; int n = 0;
    for (int j = 0; j < NBLK - 1; ++j) { int qb = j + 1;
        while (qb < NBLK) { const int lo = qb; float acc = 0.f;
            while (qb < NBLK && (qb - lo) < 8) { const float e = su_expect(qb); if (acc > 0.f && acc + e > 250.f) break; acc += e; ++qb; if (acc >= 200.f) break; }
            T.u[n].j = (unsigned char)j; T.u[n].qlo = (unsigned char)lo; T.u[n].qhi = (unsigned char)qb; T.u[n].pad = 0; ex[n] = acc; ++n; } }
    for (int i = 1; i < n; ++i) { const SelUnit u = T.u[i]; const float e = ex[i]; int k = i - 1; while (k >= 0 && ex[k] < e) { T.u[k + 1] = T.u[k]; ex[k + 1] = ex[k]; --k; } T.u[k + 1] = u; ex[k + 1] = e; }
    T.n = n; return T;
}
__device__ const SelTable g_seltab = make_sel_table();
static_assert(make_sel_table().n <= SU_MAX - 1, "selected-block unit table overflow");
}

__device__ __forceinline__ void p3_route(Frame& F) {
    const bf16* Qt = (const bf16*)(F.ws + WS_PROJ);
    const float* ksum = (const float*)(F.ws + WS_KSUM);
    unsigned* SEL = (unsigned*)(F.ws + WS_LIST);
    LAS float* ks = (LAS float*)(F.lds + RING_OFF);
    for (int w = blockIdx.x; w < 256; w += F.G) {
        const int bh = w >> 4, b = bh >> 3, h = bh & 7, t = (w & 15) * 512 + F.tid, blk = t >> 8;
        __syncthreads();
        { const f32x4 v = *(const f32x4*)(ksum + (size_t)bh * NBLK * HD + 4 * F.tid); *(LAS f32x4*)(ks + 4 * F.tid) = v; }
        __syncthreads();
        float q[64];
        { const v4u* qp = (const v4u*)(Qt + (size_t)(b * SEQ + t) * 512 + h * HD);
#pragma unroll
          for (int c8 = 0; c8 < 8; ++c8) { const v4u v = qp[c8]; q[8 * c8] = bf_lo(v.x); q[8 * c8 + 1] = bf_hi(v.x); q[8 * c8 + 2] = bf_lo(v.y); q[8 * c8 + 3] = bf_hi(v.y); q[8 * c8 + 4] = bf_lo(v.z); q[8 * c8 + 5] = bf_hi(v.z); q[8 * c8 + 6] = bf_lo(v.w); q[8 * c8 + 7] = bf_hi(v.w); } }
        float v0 = -3.0e38f, v1 = -3.0e38f, v2 = -3.0e38f; unsigned i0 = 255u, i1 = 255u, i2 = 255u;
        for (int j = 0; j < blk; ++j) { float s = 0.f;
#pragma unroll
            for (int d4 = 0; d4 < 16; ++d4) { const f32x4 kv = *(const LAS f32x4*)(ks + j * HD + 4 * d4); s += q[4 * d4] * kv.x + q[4 * d4 + 1] * kv.y + q[4 * d4 + 2] * kv.z + q[4 * d4 + 3] * kv.w; }
            if (s > v0) { v2 = v1; i2 = i1; v1 = v0; i1 = i0; v0 = s; i0 = (unsigned)j; }
            else if (s > v1) { v2 = v1; i2 = i1; v1 = s; i1 = (unsigned)j; }
            else if (s > v2) { v2 = s; i2 = (unsigned)j; } }
        SEL[(size_t)bh * SEQ + t] = i0 | (i1 << 8) | (i2 << 16) | 0xFF000000u;
    }
}

__device__ __forceinline__ void build_btab8(Frame& F, const Args& A) {
    LAS float* btab = (LAS float*)(F.lds + BTAB_OFF);
    for (int i = F.tid; i < NH * 128; i += NWAVES * 64) { const int h = i >> 7, rel = i & 127; int bk;
        if (rel < 16) bk = rel;
        else { bk = 16; const int th[15] = {19, 21, 24, 27, 31, 35, 40, 46, 52, 59, 67, 77, 87, 99, 113};
#pragma unroll
            for (int q = 0; q < 15; ++q) bk += (rel >= th[q]) ? 1 : 0; }
        btab[i] = 8.0f * A.in[7][bk * NH + h]; }
    __syncthreads();
}

constexpr int P4_LIST0 = 131072 + 6144, P4_CNT = P4_LIST0 + 2 * 4096;
static_assert(P4_CNT + 16 <= LDS_BYTES && P4_LIST0 >= TILEE_OFF + 4 * MAXTILES, "P4 LDS map");
__device__ __forceinline__ void p4_selected(Frame& F, const Args& A) {
    using namespace att;
    const bf16* Qt = (const bf16*)(F.ws + WS_PROJ); const bf16* Kt = Qt + (size_t)1 * NTOK * 512; const bf16* Vt = Qt + (size_t)2 * NTOK * 512;
    const unsigned* SEL = (const unsigned*)(F.ws + WS_LIST);
    bf16* PO = (bf16*)F.out; float* PL = (float*)((unsigned char*)F.out + 3 * PLANE * 2);
    LAS unsigned char* lds = F.lds + RING_OFF;
    LAS unsigned* cntw = (LAS unsigned*)(F.lds + P4_CNT);
    const LAS float* btab_all = (const LAS float*)(F.lds + BTAB_OFF);
    const int lane = F.lane, r32 = lane & 31, hi = lane >> 5;
    const int swz = (r32 >> 1) & 7; int kb[4];
#pragma unroll
    for (int d0 = 0; d0 < 4; ++d0) kb[d0] = r32 * 128 + (((2 * d0 + hi) ^ swz) << 4);
    const int q_ = (lane & 15) >> 2, p_ = lane & 3, g1 = (lane >> 4) & 1;
    const int vb0 = (4 * hi + q_) * 128 + ((0 ^ (q_ >> 1)) << 6) + (16 * g1 + 4 * p_) * 2, vb1 = (4 * hi + q_) * 128 + ((1 ^ (q_ >> 1)) << 6) + (16 * g1 + 4 * p_) * 2;
    const int nunits = g_seltab.n * 16;
    build_btab8(F, A);
    if (F.tid < 3) cntw[F.tid] = 0u;
    unsigned swv[4];
#define P4_SEL_LOAD(u_) do { const int ui_ = (u_) >> 4, bh_ = (u_) & 15; const int qlo_ = g_seltab.u[ui_].qlo, qhi_ = g_seltab.u[ui_].qhi; \
        _Pragma("unroll") for (int c = 0; c < 4; ++c) { const int t_ = qlo_ * MBLK + c * 512 + F.tid; swv[c] = (t_ < qhi_ * MBLK) ? SEL[(size_t)bh_ * SEQ + t_] : 0xFFFFFFFFu; } } while (0)
#define P4_DMA(u_, buf_) do { const int ui_ = (u_) >> 4, bh_ = (u_) & 15; load_kv(lds + (buf_) * 65536, Kt, Vt, bh_ >> 3, bh_ & 7, g_seltab.u[ui_].j, F.tid, F.wave); } while (0)
#define P4_LIST(u_, lb_, cw_) do { const int ui_ = (u_) >> 4; const int j_ = g_seltab.u[ui_].j, qlo_ = g_seltab.u[ui_].qlo, qhi_ = g_seltab.u[ui_].qhi; \
        LAS unsigned short* list_ = (LAS unsigned short*)(F.lds + P4_LIST0 + (lb_) * 4096); \
        _Pragma("unroll") for (int c = 0; c < 4; ++c) { if (qlo_ * MBLK + c * 512 < qhi_ * MBLK) { const int t_ = qlo_ * MBLK + c * 512 + F.tid; const unsigned sw = swv[c]; \
            const int slot_ = (t_ < qhi_ * MBLK) ? (((sw & 255u) == (unsigned)j_) ? 0 : ((((sw >> 8) & 255u) == (unsigned)j_) ? 1 : ((((sw >> 16) & 255u) == (unsigned)j_) ? 2 : -1))) : -1; \
            const unsigned long long mk = __ballot(slot_ >= 0); \
            if (mk) { unsigned base = 0u; if (lane == 0) base = __hip_atomic_fetch_add(cntw + (cw_), (unsigned)__builtin_popcountll(mk), __ATOMIC_RELAXED, __HIP_MEMORY_SCOPE_WORKGROUP); \
                base = (unsigned)__builtin_amdgcn_readfirstlane((int)base); \
                if (slot_ >= 0) list_[base + (unsigned)__builtin_popcountll(mk & ((1ull << lane) - 1ull))] = (unsigned short)(t_ | (slot_ << 13)); } } } } while (0)
    int u0 = blockIdx.x;
    if (u0 < nunits) { P4_SEL_LOAD(u0); P4_DMA(u0, 0); }
    __syncthreads();
    if (u0 < nunits) { P4_LIST(u0, 0, 0); }
    asm volatile("s_waitcnt vmcnt(0) lgkmcnt(0)" ::: "memory");
    __syncthreads();
    int it = 0;
    for (int uidx = u0; uidx < nunits; uidx += F.G, ++it) {
        const int ui = uidx >> 4, bh = uidx & 15, b = bh >> 3, h = bh & 7, j = g_seltab.u[ui].j;
        const int buf = it & 1, unext = uidx + F.G; const bool has_next = unext < nunits;
        const LAS unsigned char* kv = lds + buf * 65536;
        const LAS unsigned short* list = (const LAS unsigned short*)(F.lds + P4_LIST0 + buf * 4096);
        const LAS float* btab = btab_all + h * 128;
        const int cnt = (int)cntw[it % 3], ntiles = (cnt + 31) >> 5;
        if (F.tid == 0) cntw[(it + 2) % 3] = 0u;
        int tile = F.wave; int ent = 0; bf16x8 qr[4];
        if (tile < ntiles) { int idx = tile * 32 + r32; idx = idx < cnt ? idx : cnt - 1; ent = list[idx];
            const bf16* qp = Qt + (size_t)(b * SEQ + (ent & 8191)) * 512 + h * HD + 8 * hi;
#pragma unroll
            for (int d0 = 0; d0 < 4; ++d0) qr[d0] = *(const bf16x8*)(qp + 16 * d0); }
        if (has_next) { P4_SEL_LOAD(unext); P4_DMA(unext, buf ^ 1); }
        const float b31 = btab[127] * (0.125f * LOG2E);
        for (int rep_ = 0; rep_ < (PROBE_PHASE == 40 ? 2 : 1); ++rep_) { bool reload_ = false; if (rep_) { tile = F.wave; reload_ = true; }
        for (; tile < ntiles; tile += NWAVES) {
            if (tile != F.wave || reload_) { int idx = tile * 32 + r32; idx = idx < cnt ? idx : cnt - 1; ent = list[idx];
                const bf16* qp = Qt + (size_t)(b * SEQ + (ent & 8191)) * 512 + h * HD + 8 * hi;
#pragma unroll
                for (int d0 = 0; d0 < 4; ++d0) qr[d0] = *(const bf16x8*)(qp + 16 * d0); }
            const int tq = ent & 8191, slot = ent >> 13;
            f32x16 S[8];
#pragma unroll
            for (int kt = 0; kt < 8; ++kt) qk_tile(S[kt], kv, kt, kb, qr);
            const bool near = __ballot(tq < MBLK * (j + 1) + 112) != 0ull;
            if (near) {
#pragma unroll
                for (int kt = 0; kt < 8; ++kt)
#pragma unroll
                    for (int r = 0; r < 16; ++r) { const int rel = tq - (MBLK * j + 32 * kt + crow(r, hi)); S[kt][r] += btab[rel > 127 ? 127 : rel]; } }
            float mx = S[0][0];
#pragma unroll
            for (int kt = 0; kt < 8; ++kt)
#pragma unroll
                for (int r = 0; r < 16; ++r) mx = fmaxf(mx, S[kt][r]);
            mx = swap_max(mx);
            const float nm = -mx * C2; float l = 0.f;
#pragma unroll
            for (int kt = 0; kt < 8; ++kt)
#pragma unroll
                for (int r = 0; r < 16; ++r) { const float p = __builtin_amdgcn_exp2f(__builtin_fmaf(S[kt][r], C2, nm)); S[kt][r] = p; l += p; }
            l = swap_sum(l);
            f32x16 o0 = {}, o1 = {};
#pragma unroll
            for (int kt = 0; kt < 8; ++kt) pv_tile(o0, o1, S[kt], kv, kt, vb0, vb1);
            if (tile * 32 + r32 < cnt) { const float rl = 1.0f / l;
                bf16* dst = PO + (size_t)slot * PLANE + ((size_t)bh * SEQ + tq) * HD + 4 * hi;
#pragma unroll
                for (int g = 0; g < 4; ++g) { v2u wa, wb; wa.x = pk2(o0[4 * g] * rl, o0[4 * g + 1] * rl); wa.y = pk2(o0[4 * g + 2] * rl, o0[4 * g + 3] * rl);
                    wb.x = pk2(o1[4 * g] * rl, o1[4 * g + 1] * rl); wb.y = pk2(o1[4 * g + 2] * rl, o1[4 * g + 3] * rl);
                    *(v2u*)(dst + 8 * g) = wa; *(v2u*)(dst + 32 + 8 * g) = wb; }
                if (hi == 0) PL[((size_t)bh * SEQ + tq) * 4 + slot] = mx * C2 + (near ? 0.f : b31) + __builtin_amdgcn_logf(l); }
        }
        }
        if (has_next) { P4_LIST(unext, buf ^ 1, (it + 1) % 3); }
        asm volatile("s_waitcnt vmcnt(0) lgkmcnt(0)" ::: "memory");
        __syncthreads();
    }
#undef P4_SEL_LOAD
#undef P4_DMA
#undef P4_LIST
    __syncthreads();
}

__device__ __forceinline__ void own_tile(const LAS unsigned char* lds, const LAS float* btab, int bh, int qb, int wt, const bf16* Qt, const bf16* PO, const float* PL, bf16* AO,
                                         const int (&kb)[4], int vb0, int vb1, int r32, int hi) {
    using namespace att;
    const int b = bh >> 3, h = bh & 7, tq = qb * MBLK + 32 * wt + r32;
    bf16x8 qr[4];
    { const bf16* qp = Qt + (size_t)(b * SEQ + tq) * 512 + h * HD + 8 * hi;
#pragma unroll
      for (int d0 = 0; d0 < 4; ++d0) qr[d0] = *(const bf16x8*)(qp + 16 * d0); }
    const int nsel = qb < 3 ? qb : 3; const size_t qrow = (size_t)bh * SEQ + tq;
    f32x4 ls = (f32x4){0.f, 0.f, 0.f, 0.f};
    if (nsel > 0) ls = *(const f32x4*)(PL + qrow * 4);
    float mx = -INFINITY;
#pragma unroll 1
    for (int kt = 0; kt <= wt; ++kt) { f32x16 S; qk_tile(S, lds, kt, kb, qr);
#pragma unroll
        for (int r = 0; r < 16; ++r) { const int rel = (32 * wt + r32) - (32 * kt + crow(r, hi));
            const float bv = btab[rel < 0 ? 0 : (rel > 127 ? 127 : rel)];
            const float v = rel < 0 ? -INFINITY : S[r] + bv; mx = fmaxf(mx, v); } }
    mx = swap_max(mx);
    const float nm = -mx * C2; float l = 0.f;
    f32x16 o0 = {}, o1 = {};
#pragma unroll 1
    for (int kt = 0; kt <= wt; ++kt) { f32x16 S; qk_tile(S, lds, kt, kb, qr);
#pragma unroll
        for (int r = 0; r < 16; ++r) { const int rel = (32 * wt + r32) - (32 * kt + crow(r, hi));
            const float bv = btab[rel < 0 ? 0 : (rel > 127 ? 127 : rel)];
            const float v = rel < 0 ? -INFINITY : S[r] + bv;
            const float p = __builtin_amdgcn_exp2f(__builtin_fmaf(v, C2, nm)); S[r] = p; l += p; }
        pv_tile(o0, o1, S, lds, kt, vb0, vb1); }
    l = swap_sum(l);
    const float mo = mx * C2;
    const float ls0 = nsel > 0 ? ls.x : -INFINITY, ls1 = nsel > 1 ? ls.y : -INFINITY, ls2 = nsel > 2 ? ls.z : -INFINITY;
    const float M = fmaxf(fmaxf(mo, ls0), fmaxf(ls1, ls2));
    const float wo = __builtin_amdgcn_exp2f(mo - M), w0 = __builtin_amdgcn_exp2f(ls0 - M), w1 = __builtin_amdgcn_exp2f(ls1 - M), w2 = __builtin_amdgcn_exp2f(ls2 - M);
    const float inv = 1.0f / (l * wo + w0 + w1 + w2);
    const float fo = wo * inv, f0 = w0 * inv, f1 = w1 * inv, f2 = w2 * inv;
    const bf16* pp = PO + qrow * HD + 4 * hi;
    bf16* dst = AO + (size_t)(b * SEQ + tq) * 512 + h * HD + 4 * hi;
#pragma unroll
    for (int g = 0; g < 4; ++g) {
        float a[8];
#pragma unroll
        for (int i = 0; i < 4; ++i) { a[i] = o0[4 * g + i] * fo; a[4 + i] = o1[4 * g + i] * fo; }
        if (nsel > 0) { const v2u x = *(const v2u*)(pp + 8 * g), y = *(const v2u*)(pp + 32 + 8 * g);
            a[0] += f0 * bf_lo(x.x); a[1] += f0 * bf_hi(x.x); a[2] += f0 * bf_lo(x.y); a[3] += f0 * bf_hi(x.y); a[4] += f0 * bf_lo(y.x); a[5] += f0 * bf_hi(y.x); a[6] += f0 * bf_lo(y.y); a[7] += f0 * bf_hi(y.y); }
        if (nsel > 1) { const v2u x = *(const v2u*)(pp + PLANE + 8 * g), y = *(const v2u*)(pp + PLANE + 32 + 8 * g);
            a[0] += f1 * bf_lo(x.x); a[1] += f1 * bf_hi(x.x); a[2] += f1 * bf_lo(x.y); a[3] += f1 * bf_hi(x.y); a[4] += f1 * bf_lo(y.x); a[5] += f1 * bf_hi(y.x); a[6] += f1 * bf_lo(y.y); a[7] += f1 * bf_hi(y.y); }
        if (nsel > 2) { const v2u x = *(const v2u*)(pp + 2 * PLANE + 8 * g), y = *(const v2u*)(pp + 2 * PLANE + 32 + 8 * g);
            a[0] += f2 * bf_lo(x.x); a[1] += f2 * bf_hi(x.x); a[2] += f2 * bf_lo(x.y); a[3] += f2 * bf_hi(x.y); a[4] += f2 * bf_lo(y.x); a[5] += f2 * bf_hi(y.x); a[6] += f2 * bf_lo(y.y); a[7] += f2 * bf_hi(y.y); }
        v2u wa, wb; wa.x = pk2(a[0], a[1]); wa.y = pk2(a[2], a[3]); wb.x = pk2(a[4], a[5]); wb.y = pk2(a[6], a[7]);
        *(v2u*)(dst + 8 * g) = wa; *(v2u*)(dst + 32 + 8 * g) = wb; }
}
__device__ __forceinline__ void p5_own(Frame& F, const Args& A) {
    using namespace att;
    const bf16* Qt = (const bf16*)(F.ws + WS_PROJ); const bf16* Kt = Qt + (size_t)1 * NTOK * 512; const bf16* Vt = Qt + (size_t)2 * NTOK * 512;
    const bf16* PO = (const bf16*)F.out; const float* PL = (const float*)((const unsigned char*)F.out + 3 * PLANE * 2);
    bf16* AO = (bf16*)(F.ws + WS_AO);
    LAS unsigned char* lds = F.lds + RING_OFF;
    const LAS float* btab = (const LAS float*)(F.lds + BTAB_OFF);
    const int lane = F.lane, r32 = lane & 31, hi = lane >> 5, w = F.wave;
    const int swz = (r32 >> 1) & 7; int kb[4];
#pragma unroll
    for (int d0 = 0; d0 < 4; ++d0) kb[d0] = r32 * 128 + (((2 * d0 + hi) ^ swz) << 4);
    const int q_ = (lane & 15) >> 2, p_ = lane & 3, g1 = (lane >> 4) & 1;
    const int vb0 = (4 * hi + q_) * 128 + ((0 ^ (q_ >> 1)) << 6) + (16 * g1 + 4 * p_) * 2, vb1 = (4 * hi + q_) * 128 + ((1 ^ (q_ >> 1)) << 6) + (16 * g1 + 4 * p_) * 2;
    build_btab8(F, A);
    for (int pidx = blockIdx.x; pidx < 16 * (NBLK / 2); pidx += F.G) {
        const int bh = pidx & 15, qa = pidx >> 4, qb = NBLK - 1 - qa, b = bh >> 3, h = bh & 7;
        __syncthreads();
        load_kv(lds, Kt, Vt, b, h, qa, F.tid, F.wave);
        load_kv(lds + 65536, Kt, Vt, b, h, qb, F.tid, F.wave);
        asm volatile("s_waitcnt vmcnt(0)" ::: "memory");
        __syncthreads();
        for (int rep_ = 0; rep_ < (PROBE_PHASE == 50 ? 2 : 1); ++rep_) {
        own_tile(lds, btab + h * 128, bh, qa, w, Qt, PO, PL, AO, kb, vb0, vb1, r32, hi);
        own_tile(lds + 65536, btab + h * 128, bh, qb, 7 - w, Qt, PO, PL, AO, kb, vb0, vb1, r32, hi); }
    }
    __syncthreads();
}
__global__ void __launch_bounds__(NWAVES * 64, 2) mk_fwd(Args args) {
    extern __shared__ __attribute__((aligned(16))) unsigned char lds[];
    Frame F;
    F.lds = (LAS unsigned char*)lds;
    F.MISC = (volatile LAS unsigned*)(F.lds + MISC_OFF);
    F.tid = threadIdx.x; F.lane = F.tid & 63; F.wave = __builtin_amdgcn_readfirstlane(F.tid >> 6);
    F.G = gridDim.x; { const int bx = blockIdx.x; F.vcu = (F.G % 8 == 0) ? (bx % 8) * (F.G / 8) + bx / 8 : bx; }
    F.ws = args.ws; F.ctl = (gu32*)(args.ws + WS_CTL); F.out = args.out;
    for (int u = F.tid; u < (LDS_BYTES - LDSCTL_OFF) / 4; u += NWAVES * 64) ((LAS unsigned*)(F.lds + LDSCTL_OFF))[u] = 0u;
    __syncthreads();
    XcdBarrier bar; bar.bar = (unsigned*)(F.ctl + CW_BAR); bar.x = 0; bar.st = nullptr;
    if (N_LAUNCHES != PER_PHASE) bar = xcd_barrier_post((unsigned*)(F.ctl + CW_BAR), F.MISC + 8);
#define GRID_BAR(seam) do { if (N_LAUNCHES == PER_PHASE) { if (F.tid == 0) __hip_atomic_store(F.ctl + CW_TMO, 0xBADBA0u | (unsigned)(seam), RLX_AGENT); } else { xcd_barrier(bar); } } while (0)
    const int lo = args.ph_lo, hi = args.ph_hi;
#define IN(k) (lo <= (k) && (k) < hi)
#define PHM(k) ((PH_MASK >> (k)) & 1)
#define BOTH(k) (IN(k) && IN((k) + 1))
    bf16* PROJ = (bf16*)(F.ws + WS_PROJ);

    if (PHM(0) && IN(0)) { p0_prologue(F, args); if (PROBE_PHASE == 0) { GRID_BAR(0); p0_prologue(F, args); } if (BOTH(0)) GRID_BAR(0); }
    if (PHM(1) && IN(1)) { p1_hrows(F, args); if (PROBE_PHASE == 1) { GRID_BAR(1); p1_hrows(F, args); } if (BOTH(1)) GRID_BAR(1); }
    if (PHM(2) && IN(2)) {
        {
        pg8::Gemm g{(const bf16*)(F.ws + WS_H), (const bf16*)(F.ws + WS_WIN), NTOK, INW, D, 0};
        pg8::StaticOrder S; S.init(NTOK, INW, F.G, (int)blockIdx.x);
        pg8::EpiProj E{PROJ, args.in[6], (float*)(F.ws + WS_KSUM)};
        pg8::gemm_phase<pg8::EpiProj, pg8::StaticOrder, true, true>(F.lds + RING_OFF, g, S, E);
        }
        if (PROBE_PHASE == 2) { GRID_BAR(2);
        pg8::Gemm g{(const bf16*)(F.ws + WS_H), (const bf16*)(F.ws + WS_WIN), NTOK, INW, D, 0};
        pg8::StaticOrder S; S.init(NTOK, INW, F.G, (int)blockIdx.x);
        pg8::EpiProj E{PROJ, args.in[6], (float*)(F.ws + WS_KSUM)};
        pg8::gemm_phase<pg8::EpiProj, pg8::StaticOrder, true, true>(F.lds + RING_OFF, g, S, E);
        }
        if (BOTH(2)) GRID_BAR(2);
    }
    if (PROBE_PHASE == 20) { GRID_BAR(20); GRID_BAR(20); GRID_BAR(20); GRID_BAR(20); GRID_BAR(20); GRID_BAR(20); GRID_BAR(20); GRID_BAR(20); }
    if (PHM(3) && IN(3)) { p3_pooldiff(F, args); p3_route(F); if (PROBE_PHASE == 3) { GRID_BAR(3); p3_pooldiff(F, args); p3_route(F); } if (BOTH(3)) GRID_BAR(3); }
#if defined(ATTN_NAIVE)
    if (PHM(4) && IN(4)) { p4_attn_naive(F, args); if (PROBE_PHASE == 4) { GRID_BAR(4); p4_attn_naive(F, args); } if (BOTH(4)) GRID_BAR(4); }
#else
    if (PHM(4) && IN(4)) { p4_selected(F, args); if (PROBE_PHASE == 4) { GRID_BAR(4); p4_selected(F, args); } if (BOTH(4)) GRID_BAR(4); }
    if (PHM(5) && IN(5)) { p5_own(F, args); if (PROBE_PHASE == 5) { GRID_BAR(5); p5_own(F, args); } if (BOTH(5)) GRID_BAR(5); }
#endif
    if (PHM(6) && IN(6)) {
        {
        bf16* T = (bf16*)(F.ws + WS_T);
        { pg8::Gemm g{(const bf16*)(F.ws + WS_AO), (const bf16*)(F.ws + WS_WBA), NTOK, D, AW, 0};
          pg8::StaticOrder S; S.init(NTOK, D, F.G, (int)blockIdx.x);
          pg8::EpiGate<false> E{PROJ + (size_t)4 * NTOK * 512, T};
          pg8::gemm_phase<pg8::EpiGate<false>, pg8::StaticOrder, false, true>(F.lds + RING_OFF, g, S, E); }
        VM_WAIT(); __syncthreads();
        { pg8::Gemm g{(const bf16*)(F.ws + WS_DP), (const bf16*)(F.ws + WS_WCOMB), NTOK, D, PW, 0};
          pg8::StaticOrder S; S.init(NTOK, D, F.G, (int)blockIdx.x);
          pg8::EpiGate<true> E{PROJ + (size_t)6 * NTOK * 512, T};
          pg8::gemm_phase<pg8::EpiGate<true>, pg8::StaticOrder, false, true>(F.lds + RING_OFF, g, S, E); }
        }
        if (PROBE_PHASE == 6) { GRID_BAR(6);
        bf16* T = (bf16*)(F.ws + WS_T);
        { pg8::Gemm g{(const bf16*)(F.ws + WS_AO), (const bf16*)(F.ws + WS_WBA), NTOK, D, AW, 0};
          pg8::StaticOrder S; S.init(NTOK, D, F.G, (int)blockIdx.x);
          pg8::EpiGate<false> E{PROJ + (size_t)4 * NTOK * 512, T};
          pg8::gemm_phase<pg8::EpiGate<false>, pg8::StaticOrder, false, true>(F.lds + RING_OFF, g, S, E); }
        VM_WAIT(); __syncthreads();
        { pg8::Gemm g{(const bf16*)(F.ws + WS_DP), (const bf16*)(F.ws + WS_WCOMB), NTOK, D, PW, 0};
          pg8::StaticOrder S; S.init(NTOK, D, F.G, (int)blockIdx.x);
          pg8::EpiGate<true> E{PROJ + (size_t)6 * NTOK * 512, T};
          pg8::gemm_phase<pg8::EpiGate<true>, pg8::StaticOrder, false, true>(F.lds + RING_OFF, g, S, E); }
        }
        if (BOTH(6)) GRID_BAR(6);
    }
    if (PHM(7) && IN(7)) {
        {
        pg8::Gemm g{(const bf16*)(F.ws + WS_T), (const bf16*)(F.ws + WS_WOUT), NTOK, D, D, 0};
        pg8::StaticOrder S; S.init(NTOK, D, F.G, (int)blockIdx.x);
        pg8::EpiRes E{args.in[0], (bf16*)(F.ws + WS_X1), (const float*)(F.ws + WS_MOD)};
        pg8::gemm_phase<pg8::EpiRes, pg8::StaticOrder, false, true>(F.lds + RING_OFF, g, S, E);
        }
        if (PROBE_PHASE == 7) { GRID_BAR(7);
        pg8::Gemm g{(const bf16*)(F.ws + WS_T), (const bf16*)(F.ws + WS_WOUT), NTOK, D, D, 0};
        pg8::StaticOrder S; S.init(NTOK, D, F.G, (int)blockIdx.x);
        pg8::EpiRes E{args.in[0], (bf16*)(F.ws + WS_X1), (const float*)(F.ws + WS_MOD)};
        pg8::gemm_phase<pg8::EpiRes, pg8::StaticOrder, false, true>(F.lds + RING_OFF, g, S, E);
        }
        if (BOTH(7)) GRID_BAR(7);
    }
    if (PHM(8) && IN(8)) { p8_norm_route(F, args); if (PROBE_PHASE == 8) { GRID_BAR(8); if (F.tid < NE && blockIdx.x == 0) __hip_atomic_store((unsigned*)(F.ctl + CW_ECNT + 64 * F.tid), 0u, RLX_AGENT); GRID_BAR(8); p8_norm_route(F, args); } if (BOTH(8)) GRID_BAR(8); }
    if (PHM(10) && IN(10)) {
        {
        build_tables(F);
        const int ntiles = ((const LAS int*)(F.lds + TOFF_OFF))[NE];
        pg8::Gemm g{(const bf16*)(F.ws + WS_H), (const bf16*)(F.ws + WS_WGU), ntiles * 256, D, D, (size_t)D * D * 2, (const int*)(F.ws + WS_LIST), NTOK};
        pg8::GroupedOrder S; S.so.init(ntiles * 256, D, F.G, (int)blockIdx.x); S.tile_e = (const LAS int*)(F.lds + TILEE_OFF); S.toff = (const LAS int*)(F.lds + TOFF_OFF); S.ecnt = (const LAS int*)(F.lds + ECNT_OFF);
        pg8::EpiSwiglu E{(bf16*)(F.ws + WS_ACT)};
        pg8::gemm_phase<pg8::EpiSwiglu, pg8::GroupedOrder, true, true, true>(F.lds + RING_OFF, g, S, E);
        }
        if (PROBE_PHASE == 10) { GRID_BAR(10);
        build_tables(F);
        const int ntiles = ((const LAS int*)(F.lds + TOFF_OFF))[NE];
        pg8::Gemm g{(const bf16*)(F.ws + WS_H), (const bf16*)(F.ws + WS_WGU), ntiles * 256, D, D, (size_t)D * D * 2, (const int*)(F.ws + WS_LIST), NTOK};
        pg8::GroupedOrder S; S.so.init(ntiles * 256, D, F.G, (int)blockIdx.x); S.tile_e = (const LAS int*)(F.lds + TILEE_OFF); S.toff = (const LAS int*)(F.lds + TOFF_OFF); S.ecnt = (const LAS int*)(F.lds + ECNT_OFF);
        pg8::EpiSwiglu E{(bf16*)(F.ws + WS_ACT)};
        pg8::gemm_phase<pg8::EpiSwiglu, pg8::GroupedOrder, true, true, true>(F.lds + RING_OFF, g, S, E);
        }
        if (BOTH(10)) GRID_BAR(10);
    }
    if (PHM(11) && IN(11)) {
        {
        build_tables(F);
        const int ntiles = ((const LAS int*)(F.lds + TOFF_OFF))[NE];
        pg8::Gemm g{(const bf16*)(F.ws + WS_ACT), (const bf16*)(F.ws + WS_WD), ntiles * 256, D, DE, (size_t)D * DE * 2};
        pg8::GroupedOrder S; S.so.init(ntiles * 256, D, F.G, (int)blockIdx.x); S.tile_e = (const LAS int*)(F.lds + TILEE_OFF); S.toff = (const LAS int*)(F.lds + TOFF_OFF); S.ecnt = (const LAS int*)(F.lds + ECNT_OFF);
        pg8::EpiY E{(bf16*)(F.ws + WS_Y)};
        pg8::gemm_phase<pg8::EpiY, pg8::GroupedOrder, true, true>(F.lds + RING_OFF, g, S, E);
        }
        if (PROBE_PHASE == 11) { GRID_BAR(11);
        build_tables(F);
        const int ntiles = ((const LAS int*)(F.lds + TOFF_OFF))[NE];
        pg8::Gemm g{(const bf16*)(F.ws + WS_ACT), (const bf16*)(F.ws + WS_WD), ntiles * 256, D, DE, (size_t)D * DE * 2};
        pg8::GroupedOrder S; S.so.init(ntiles * 256, D, F.G, (int)blockIdx.x); S.tile_e = (const LAS int*)(F.lds + TILEE_OFF); S.toff = (const LAS int*)(F.lds + TOFF_OFF); S.ecnt = (const LAS int*)(F.lds + ECNT_OFF);
        pg8::EpiY E{(bf16*)(F.ws + WS_Y)};
        pg8::gemm_phase<pg8::EpiY, pg8::GroupedOrder, true, true>(F.lds + RING_OFF, g, S, E);
        }
        if (BOTH(11)) GRID_BAR(11);
    }
    if (PHM(12) && IN(12)) { p11_final(F, args); }
#undef IN
#undef BOTH
}

extern "C" void kernel_launch(void* const* d_in, const int* in_sizes, int n_in, void* d_out, int out_size, void* d_ws, size_t ws_size, hipStream_t stream) {
    static int grid = 0;
    if (grid == 0) {
        if (n_in != 22 || in_sizes[0] != NTOK * D || out_size != NTOK * D || ws_size < WS_END) { fprintf(stderr, "kernel_launch: unexpected shapes (n_in %d, in0 %d, out %d, ws %zu); nothing launched\n", n_in, n_in > 0 ? in_sizes[0] : -1, out_size, ws_size); grid = -1; return; }
        int dev = 0, cus = 0, per_cu = 0;
        if (hipGetDevice(&dev) != hipSuccess || hipDeviceGetAttribute(&cus, hipDeviceAttributeMultiprocessorCount, dev) != hipSuccess) { fprintf(stderr, "kernel_launch: device query failed\n"); grid = -1; return; }
        if (hipFuncSetAttribute((const void*)mk_fwd, hipFuncAttributeMaxDynamicSharedMemorySize, LDS_BYTES) != hipSuccess) { fprintf(stderr, "kernel_launch: hipFuncSetAttribute failed\n"); grid = -1; return; }
        if (hipOccupancyMaxActiveBlocksPerMultiprocessor(&per_cu, (const void*)mk_fwd, NWAVES * 64, LDS_BYTES) != hipSuccess || per_cu < 1)
            fprintf(stderr, "kernel_launch: note: occupancy query reports %d workgroups per CU\n", per_cu);
        (void)hipGetLastError();
        grid = cus;
    }
    if (grid < 0) return;
    if (hipMemsetAsync((char*)d_ws + WS_CTL, 0, CTL_ZERO_BYTES, stream) != hipSuccess) { fprintf(stderr, "kernel_launch: memset failed\n"); return; }
    Args a{};
    for (int i = 0; i < 22; ++i) a.in[i] = (const float*)d_in[i];
    a.out = (float*)d_out; a.ws = (unsigned char*)d_ws;
    if (N_LAUNCHES == 1) { a.ph_lo = 0; a.ph_hi = PER_PHASE; hipLaunchKernelGGL(mk_fwd, dim3(grid), dim3(NWAVES * 64), LDS_BYTES, stream, a); }
    else for (int li = 0; li < PER_PHASE; ++li) { a.ph_lo = li; a.ph_hi = li + 1; hipLaunchKernelGGL(mk_fwd, dim3(grid), dim3(NWAVES * 64), LDS_BYTES, stream, a); }
}
```
